# Optimizing an MI355X kernel written in HIP

```python
import jax, jax.numpy as jnp
from jax import lax
import numpy as np

D_MODEL = 1024
BATCH = 2
SEQ = 8192
DEPTH = 4

CHUNK = 64
N_LEFT_CHUNKS = 8
BAND = (N_LEFT_CHUNKS + 1) * CHUNK
HEAD_DIM = 64
N_HEADS_A = 8
N_HEADS_B = 8
A_W = N_HEADS_A * HEAD_DIM
B_W = N_HEADS_B * HEAD_DIM
MIX_W = A_W + B_W
REL_CLIP = 256
Q_BLOCK = 128
LRU_WIDTH = D_MODEL
LRU_BLOCKS = 4
LRU_BLOCK_W = LRU_WIDTH // LRU_BLOCKS
CONV_WIDTH = 4
LRU_C = 8.0
D_FF = -(-(8 * D_MODEL) // (3 * 256)) * 256
RMS_EPS = 1e-6
N_ATTN_LAYERS = (DEPTH + 1) // 2
N_REC_LAYERS = DEPTH // 2

kernel_name = "hybrid_chunked_sb_rglru_trunk"


def rmsnorm(x, g):
    xf = x.astype(jnp.float32)
    y = xf * lax.rsqrt(jnp.mean(xf * xf, axis=-1, keepdims=True) + RMS_EPS)
    return (y * g.astype(jnp.float32)).astype(x.dtype)


def chunked_relpos_attention(q, k, v, rel_bias):
    b, s, h, dh = q.shape
    nc = s // CHUNK
    qc = q.reshape(b, nc, CHUNK, h, dh)

    def gather_band(t):
        tc = t.reshape(b, nc, CHUNK, h, dh)
        tp = jnp.pad(tc, ((0, 0), (N_LEFT_CHUNKS, 0), (0, 0), (0, 0), (0, 0)))
        return jnp.concatenate([tp[:, j:j + nc] for j in range(N_LEFT_CHUNKS + 1)], axis=2)

    kb, vb = gather_band(k), gather_band(v)
    scores = jnp.einsum('bcqhd,bckhd->bhcqk', qc, kb).astype(jnp.float32) * (dh ** -0.5)
    qpos = N_LEFT_CHUNKS * CHUNK + jnp.arange(CHUNK)
    kpos = jnp.arange(BAND)
    rel = jnp.clip(qpos[:, None] - kpos[None, :], -REL_CLIP, REL_CLIP) + REL_CLIP
    bias = rel_bias[:, rel].astype(jnp.float32)
    key_chunk = jnp.arange(nc)[:, None] - N_LEFT_CHUNKS + (kpos // CHUNK)[None, :]
    valid = key_chunk >= 0
    scores = scores + bias[None, :, None, :, :]
    scores = jnp.where(valid[None, None, :, None, :], scores, -jnp.inf)
    p = jax.nn.softmax(scores, axis=-1).astype(v.dtype)
    o = jnp.einsum('bhcqk,bckhd->bcqhd', p, vb)
    return o.reshape(b, s, h * dh)


def stick_breaking_attention(q, k, v):
    b, s, h, dh = q.shape
    nb = s // Q_BLOCK
    scale = dh ** -0.5
    kpos = jnp.arange(s)
    q_blocks = q.reshape(b, nb, Q_BLOCK, h, dh).transpose(1, 0, 2, 3, 4)

    def one_block(args):
        q_blk, blk = args
        z = jnp.einsum('bqhd,bkhd->bhqk', q_blk, k).astype(jnp.float32) * scale
        qpos = blk * Q_BLOCK + jnp.arange(Q_BLOCK)
        causal = kpos[None, :] < qpos[:, None]
        log_beta = jax.nn.log_sigmoid(z)
        log_1m_beta = jnp.where(causal, jax.nn.log_sigmoid(-z), 0.0)
        after = lax.cumsum(log_1m_beta, axis=3, reverse=True) - log_1m_beta
        w = jnp.where(causal, jnp.exp(log_beta + after), 0.0).astype(v.dtype)
        return jnp.einsum('bhqk,bkhd->bqhd', w, v)

    o = lax.map(one_block, (q_blocks, jnp.arange(nb)))
    return o.transpose(1, 0, 2, 3, 4).reshape(b, s, h * dh)


def attention_mixer(h, w_in, rel_bias, w_out):
    b, s, _ = h.shape
    proj = h @ w_in
    part_a, part_b = proj[..., :3 * A_W], proj[..., 3 * A_W:]
    qa, ka, va = [t.reshape(b, s, N_HEADS_A, HEAD_DIM) for t in jnp.split(part_a, 3, axis=-1)]
    qs, ks, vs = [t.reshape(b, s, N_HEADS_B, HEAD_DIM) for t in jnp.split(part_b, 3, axis=-1)]
    out_a = chunked_relpos_attention(qa, ka, va, rel_bias)
    out_b = stick_breaking_attention(qs, ks, vs)
    return jnp.concatenate([out_a, out_b], axis=-1) @ w_out


def recurrent_mixer(h, w_in, conv_w, conv_b, w_a, b_a, w_i, b_i, lam, w_out):
    b, s, _ = h.shape
    proj = h @ w_in
    gate, xr = jnp.split(proj, 2, axis=-1)
    gate = jax.nn.gelu(gate, approximate=True)
    xc = lax.conv_general_dilated(
        xr, conv_w, window_strides=(1,), padding=[(CONV_WIDTH - 1, 0)],
        dimension_numbers=('NWC', 'WIO', 'NWC'), feature_group_count=LRU_WIDTH) + conv_b
    xg = xc.reshape(b, s, LRU_BLOCKS, LRU_BLOCK_W)
    r = jax.nn.sigmoid(jnp.einsum('bsni,nij->bsnj', xg, w_a) + b_a).reshape(b, s, LRU_WIDTH)
    i = jax.nn.sigmoid(jnp.einsum('bsni,nij->bsnj', xg, w_i) + b_i).reshape(b, s, LRU_WIDTH)
    log_a = -LRU_C * r.astype(jnp.float32) * jax.nn.softplus(-lam.astype(jnp.float32))
    a = jnp.exp(log_a)
    mult = jnp.sqrt(-jnp.expm1(2.0 * log_a))
    u = mult * (i * xc).astype(jnp.float32)

    def combine(left, right):
        a1, b1 = left
        a2, b2 = right
        return a1 * a2, a2 * b1 + b2

    _, hs = lax.associative_scan(combine, (a, u), axis=1)
    return (hs.astype(h.dtype) * gate) @ w_out


def swiglu(h, w_gate, w_up, w_down):
    return (jax.nn.silu(h @ w_gate) * (h @ w_up)) @ w_down


def setup_inputs(seed: int = 0) -> dict:
    key = jax.random.key(seed)
    ks = jax.random.split(key, 24)
    f32 = jnp.float32

    def nrm(k, shape, fan_in):
        return jax.random.normal(k, shape, f32) * (fan_in ** -0.5)

    def gain(k, shape):
        return 1.0 + 0.05 * jax.random.normal(k, shape, f32)

    u = jax.random.uniform(ks[12], (N_REC_LAYERS, LRU_WIDTH), f32, 0.9, 0.999)
    base = u ** (1.0 / LRU_C)
    lam = jnp.log(base) - jnp.log1p(-base)
    return {
        'x': jax.random.normal(ks[0], (BATCH, SEQ, D_MODEL), f32),
        'attn_w_in': nrm(ks[1], (N_ATTN_LAYERS, D_MODEL, 3 * MIX_W), D_MODEL),
        'attn_rel_bias': 0.2 * jax.random.normal(ks[2], (N_ATTN_LAYERS, N_HEADS_A, 2 * REL_CLIP + 1), f32),
        'attn_w_out': nrm(ks[3], (N_ATTN_LAYERS, MIX_W, D_MODEL), MIX_W),
        'rg_w_in': nrm(ks[4], (N_REC_LAYERS, D_MODEL, 2 * LRU_WIDTH), D_MODEL),
        'rg_conv_w': nrm(ks[5], (N_REC_LAYERS, CONV_WIDTH, 1, LRU_WIDTH), CONV_WIDTH),
        'rg_conv_b': 0.01 * jax.random.normal(ks[6], (N_REC_LAYERS, LRU_WIDTH), f32),
        'rg_w_a': nrm(ks[7], (N_REC_LAYERS, LRU_BLOCKS, LRU_BLOCK_W, LRU_BLOCK_W), LRU_BLOCK_W),
        'rg_b_a': 0.01 * jax.random.normal(ks[8], (N_REC_LAYERS, LRU_BLOCKS, LRU_BLOCK_W), f32),
        'rg_w_i': nrm(ks[9], (N_REC_LAYERS, LRU_BLOCKS, LRU_BLOCK_W, LRU_BLOCK_W), LRU_BLOCK_W),
        'rg_b_i': 0.01 * jax.random.normal(ks[10], (N_REC_LAYERS, LRU_BLOCKS, LRU_BLOCK_W), f32),
        'rg_lambda': lam,
        'rg_w_out': nrm(ks[11], (N_REC_LAYERS, LRU_WIDTH, D_MODEL), LRU_WIDTH),
        'norm_mix_pre': gain(ks[13], (DEPTH, D_MODEL)),
        'norm_mix_post': gain(ks[14], (DEPTH, D_MODEL)),
        'norm_ffn_pre': gain(ks[15], (DEPTH, D_MODEL)),
        'norm_ffn_post': gain(ks[16], (DEPTH, D_MODEL)),
        'ffn_w_gate': nrm(ks[17], (DEPTH, D_MODEL, D_FF), D_MODEL),
        'ffn_w_up': nrm(ks[18], (DEPTH, D_MODEL, D_FF), D_MODEL),
        'ffn_w_down': nrm(ks[19], (DEPTH, D_FF, D_MODEL), D_FF),
    }


def reference(x, attn_w_in, attn_rel_bias, attn_w_out, rg_w_in, rg_conv_w, rg_conv_b,
              rg_w_a, rg_b_a, rg_w_i, rg_b_i, rg_lambda, rg_w_out,
              norm_mix_pre, norm_mix_post, norm_ffn_pre, norm_ffn_post,
              ffn_w_gate, ffn_w_up, ffn_w_down):
    for layer in range(DEPTH):
        j = layer // 2
        h = rmsnorm(x, norm_mix_pre[layer])
        if layer % 2 == 0:
            m = attention_mixer(h, attn_w_in[j], attn_rel_bias[j], attn_w_out[j])
        else:
            m = recurrent_mixer(h, rg_w_in[j], rg_conv_w[j], rg_conv_b[j], rg_w_a[j], rg_b_a[j],
                                rg_w_i[j], rg_b_i[j], rg_lambda[j], rg_w_out[j])
        x = x + rmsnorm(m, norm_mix_post[layer])
        h = rmsnorm(x, norm_ffn_pre[layer])
        f = swiglu(h, ffn_w_gate[layer], ffn_w_up[layer], ffn_w_down[layer])
        x = x + rmsnorm(f, norm_ffn_post[layer])
    return x
```

```cpp
#include <hip/hip_runtime.h>
#include <hip/hip_cooperative_groups.h>
#include <cstdio>
#include <cstdint>
namespace cg = cooperative_groups;

#define LAS __attribute__((address_space(3)))
typedef unsigned short bf16_t;
typedef short bf16x8 __attribute__((ext_vector_type(8)));
typedef float f32x4 __attribute__((ext_vector_type(4)));
typedef float f32x2 __attribute__((ext_vector_type(2)));
typedef float f32x16 __attribute__((ext_vector_type(16)));
typedef unsigned u32x4 __attribute__((ext_vector_type(4)));
typedef unsigned u32x2 __attribute__((ext_vector_type(2)));
typedef __bf16 bf16x2_t __attribute__((ext_vector_type(2)));

constexpr int BATCH = 2, SEQ = 8192, DM = 1024, DEPTH = 4, M = BATCH * SEQ;
constexpr int DFF = 2816, QKVW = 3072;
constexpr float RMS_EPS = 1e-6f;
constexpr float LOG2E = 1.4426950408889634f;

__device__ __forceinline__ unsigned cvtpk(float lo, float hi) { f32x2 v = {lo, hi}; bf16x2_t b = __builtin_convertvector(v, bf16x2_t); return __builtin_bit_cast(unsigned, b); }
__device__ __forceinline__ float bf_lo(unsigned w) { return __uint_as_float(w << 16); }
__device__ __forceinline__ float bf_hi(unsigned w) { return __uint_as_float(w & 0xffff0000u); }
__device__ __forceinline__ float fast_exp(float x) { return __builtin_amdgcn_exp2f(x * LOG2E); }
__device__ __forceinline__ float fast_sigmoid(float x) { return __builtin_amdgcn_rcpf(1.0f + fast_exp(-x)); }
__device__ __forceinline__ float silu_f(float x) { return x * fast_sigmoid(x); }
__device__ __forceinline__ float gelu_tanh_f(float x) { const float t = 1.5957691216057308f * (x + 0.044715f * x * x * x); return x * fast_sigmoid(t); }

namespace pg8 {
constexpr int BM = 256, BK = 64, HALF = 128, HTB = HALF * BK * 2, STAGE_BYTES = 8 * HTB, NXCD = 8, WGM = 8;

__host__ __device__ __forceinline__ int lds_byte(int r, int c) { const int st = (r >> 4) * 2 + (c >> 5), rr = r & 15, cc = c & 31, ob = rr * 64 + cc * 2; return st * 1024 + (ob ^ (((ob >> 9) & 1) << 5)); }
__host__ __device__ __forceinline__ void stage_rc(int b, int& R, int& C) { const int st = b / 1024, sb = b % 1024, swz = sb ^ (((sb >> 9) & 1) << 5); R = (st >> 1) * 16 + swz / 64; C = (st & 1) * 32 + (swz % 64) / 2; }
__host__ __device__ __forceinline__ int perm32(int rho) { const int n = rho >> 4, i = rho & 15; return 8 * (i >> 2) + 4 * n + (i & 3); }

struct Unit { int pm, pn; };
struct Gemm { const bf16_t* A; const bf16_t* Bt; int K, lda, ldb, apn_shift, apn_elems; };

struct StaticOrder {
    int nM, nN, nwg, G, c;
    __host__ __device__ void init(int M_, int N_, int G_, int c_) { nM = M_ / BM; nN = N_ / BM; nwg = nM * nN; G = G_; c = c_; }
    __host__ __device__ bool next(int i, Unit& u) const {
        const long L = (long)i * G + c; if (L >= nwg) return false;
        int wgid = (int)L; { const int q = nwg / NXCD, r = nwg % NXCD, xcd = wgid % NXCD, off = wgid / NXCD; wgid = (xcd < r ? xcd * (q + 1) : r * (q + 1) + (xcd - r) * q) + off; }
        const int nig = WGM * nN, gid = wgid / nig, fm = gid * WGM, gsz = (nM - fm) < WGM ? (nM - fm) : WGM;
        u.pm = fm + ((wgid % nig) % gsz); u.pn = (wgid % nig) / gsz; return true;
    }
};

enum { EPI_STORE = 0, EPI_SWIGLU = 1, EPI_RECIN = 2, EPI_GATES = 3 };

struct Epi {
    int mode; unsigned char* p0; unsigned char* p1; int ldc;
    __device__ __forceinline__ void operator()(const f32x4 (&acc)[2][2][4][2], const Unit& u, int wr, int wc, int fr, int fq) const {
        const int row0 = u.pm * BM + wr * 64 + fr;
        if (mode == EPI_STORE) {
            bf16_t* O = (bf16_t*)p0; const int col0 = u.pn * BM + wc * 32 + 8 * fq;
#pragma unroll
            for (int ai = 0; ai < 2; ++ai)
#pragma unroll
                for (int m = 0; m < 4; ++m) { bf16_t* rowp = O + (size_t)(row0 + ai * HALF + m * 16) * ldc + col0;
#pragma unroll
                    for (int bj = 0; bj < 2; ++bj) { const f32x4 v0 = acc[ai][bj][m][0], v1 = acc[ai][bj][m][1];
                        u32x4 w; w.x = cvtpk(v0[0], v0[1]); w.y = cvtpk(v0[2], v0[3]); w.z = cvtpk(v1[0], v1[1]); w.w = cvtpk(v1[2], v1[3]);
                        *(u32x4*)(rowp + bj * HALF) = w; } }
        } else if (mode == EPI_SWIGLU) {
            bf16_t* O = (bf16_t*)p0; const int col0 = u.pn * HALF + wc * 32 + 8 * fq;
#pragma unroll
            for (int ai = 0; ai < 2; ++ai)
#pragma unroll
                for (int m = 0; m < 4; ++m) { bf16_t* rowp = O + (size_t)(row0 + ai * HALF + m * 16) * ldc + col0;
                    const f32x4 g0 = acc[ai][0][m][0], g1 = acc[ai][0][m][1], u0 = acc[ai][1][m][0], u1 = acc[ai][1][m][1];
                    u32x4 w; w.x = cvtpk(silu_f(g0[0]) * u0[0], silu_f(g0[1]) * u0[1]); w.y = cvtpk(silu_f(g0[2]) * u0[2], silu_f(g0[3]) * u0[3]);
                    w.z = cvtpk(silu_f(g1[0]) * u1[0], silu_f(g1[1]) * u1[1]); w.w = cvtpk(silu_f(g1[2]) * u1[2], silu_f(g1[3]) * u1[3]);
                    *(u32x4*)rowp = w; }
        } else if (mode == EPI_RECIN) {
            const bool isg = u.pn < 4; bf16_t* base = (bf16_t*)(isg ? p0 : p1);
            const int col0 = (u.pn & 3) * BM + wc * 32 + 8 * fq;
#pragma unroll
            for (int ai = 0; ai < 2; ++ai)
#pragma unroll
                for (int m = 0; m < 4; ++m) { bf16_t* rowp = base + (size_t)(row0 + ai * HALF + m * 16) * DM + col0;
#pragma unroll
                    for (int bj = 0; bj < 2; ++bj) { f32x4 v0 = acc[ai][bj][m][0], v1 = acc[ai][bj][m][1];
                        if (isg) {
#pragma unroll
                            for (int e = 0; e < 4; ++e) { v0[e] = gelu_tanh_f(v0[e]); v1[e] = gelu_tanh_f(v1[e]); } }
                        u32x4 w; w.x = cvtpk(v0[0], v0[1]); w.y = cvtpk(v0[2], v0[3]); w.z = cvtpk(v1[0], v1[1]); w.w = cvtpk(v1[2], v1[3]);
                        *(u32x4*)(rowp + bj * HALF) = w; } }
        } else {
            const int ch0 = u.pn * HALF + wc * 32 + 8 * fq; const float* cst = (const float*)p1;
            const bf16_t* XC = (const bf16_t*)(p0 + (196u << 20)); bf16_t* LA = (bf16_t*)(p0 + (164u << 20)); bf16_t* U = (bf16_t*)(p0 + (100u << 20));
#pragma unroll
            for (int n = 0; n < 2; ++n) {
                const f32x4 vba = *(const f32x4*)(cst + ch0 + 4 * n), vbi = *(const f32x4*)(cst + 1024 + ch0 + 4 * n), nsp = *(const f32x4*)(cst + 2048 + ch0 + 4 * n);
#pragma unroll
                for (int ai = 0; ai < 2; ++ai)
#pragma unroll
                    for (int m = 0; m < 4; ++m) { const size_t off = (size_t)(row0 + ai * HALF + m * 16) * DM + ch0 + 4 * n;
                        const u32x2 xw = *(const u32x2*)(XC + off);
                        const float xc[4] = {bf_lo(xw.x), bf_hi(xw.x), bf_lo(xw.y), bf_hi(xw.y)};
                        float la[4], uu[4];
#pragma unroll
                        for (int e = 0; e < 4; ++e) { const float pa = acc[ai][0][m][n][e] + vba[e], pi = acc[ai][1][m][n][e] + vbi[e];
                            const float r = fast_sigmoid(pa), ig = fast_sigmoid(pi);
                            la[e] = nsp[e] * r;
                            const float x2 = 2.0f * la[e];
                            const float ser = -x2 * (1.0f + x2 * (0.5f + x2 * (0.16666667f + x2 * (0.041666668f + x2 * (0.008333334f + x2 * (0.0013888889f + x2 * 0.0001984127f))))));
                            const float om = x2 > -0.3f ? ser : 1.0f - fast_exp(x2);
                            uu[e] = __builtin_amdgcn_sqrtf(om) * ig * xc[e]; }
                        u32x2 w1, w2; w1.x = cvtpk(la[0], la[1]); w1.y = cvtpk(la[2], la[3]); w2.x = cvtpk(uu[0], uu[1]); w2.y = cvtpk(uu[2], uu[3]);
                        *(u32x2*)(LA + off) = w1; *(u32x2*)(U + off) = w2;
                        asm volatile("" ::: "memory"); }
            }
        }
    }
};

template <bool ALIGN_EPI>
__device__ __forceinline__ void gemm_phase(LAS unsigned char* lds, const Gemm g, const StaticOrder& S, const Epi& E) {
    const int tid = threadIdx.x, wid = __builtin_amdgcn_readfirstlane(tid >> 6), lane = tid & 63, wr = wid >> 2, wc = wid & 3, fr = lane & 15, fq = lane >> 4;
    const int K = g.K, nt = K / BK;
    unsigned voffA[2], voffB[2];
#pragma unroll
    for (int i = 0; i < 2; ++i) { int R, C; stage_rc(tid * 16 + i * 8192, R, C); const int Rb = (R & ~31) + perm32(R & 31);
        voffA[i] = (unsigned)(R * g.lda + C) * 2u; voffB[i] = (unsigned)(Rb * g.ldb + C) * 2u; }
    constexpr unsigned kstep = BK * 2;
    const unsigned hstepA = (unsigned)(HALF * g.lda * 2), hstepB = (unsigned)(HALF * g.ldb * 2);
    const unsigned tstepA = 2 * hstepA, tstepB = 2 * hstepB;
    const unsigned ldsw = (unsigned)wid * 1024u;
    const int aoff = lds_byte(wr * 64 + fr, fq * 8), boff = lds_byte(wc * 32 + fr, fq * 8);
#define PG8_SA(b, h) (((b) * 2 + (h)) * HTB)
#define PG8_SB(b, h) ((4 + (b) * 2 + (h)) * HTB)
#define PG8_STAGE(bufoff, gbase, soff, voff) do { _Pragma("unroll") for (int _i = 0; _i < 2; ++_i) \
        __builtin_amdgcn_global_load_lds((const unsigned*)((gbase) + (size_t)(unsigned)((soff) + (voff)[_i])), (LAS unsigned*)(lds + (bufoff) + ldsw + _i * 8192), 16, 0, 0); } while (0)
#define PG8_LDA(dst, b, h) do { _Pragma("unroll") for (int m = 0; m < 4; ++m) _Pragma("unroll") for (int k = 0; k < 2; ++k) dst[m][k] = *(const LAS bf16x8*)(lds + PG8_SA(b, h) + aoff + m * 2048 + k * 1024); } while (0)
#define PG8_LDB(dst, b, h) do { _Pragma("unroll") for (int n = 0; n < 2; ++n) _Pragma("unroll") for (int k = 0; k < 2; ++k) dst[n][k] = *(const LAS bf16x8*)(lds + PG8_SB(b, h) + boff + n * 2048 + k * 1024); } while (0)
#define PG8_MMA(ai, bj, At, Bt) do { __builtin_amdgcn_s_setprio(1); _Pragma("unroll") for (int m = 0; m < 4; ++m) _Pragma("unroll") for (int n = 0; n < 2; ++n) _Pragma("unroll") for (int k = 0; k < 2; ++k) \
        acc[ai][bj][m][n] = __builtin_amdgcn_mfma_f32_16x16x32_bf16(Bt[n][k], At[m][k], acc[ai][bj][m][n], 0, 0, 0); __builtin_amdgcn_s_setprio(0); } while (0)
#define PG8_WAIT_V(n) asm volatile("s_waitcnt vmcnt(" #n ")" ::: "memory")
#define PG8_WAIT_L(n) asm volatile("s_waitcnt lgkmcnt(" #n ")" ::: "memory")
#define PG8_BAR __builtin_amdgcn_s_barrier()
#define PG8_SCHED __builtin_amdgcn_sched_barrier(0)
#define PG8_UA(u) ((unsigned)(u).pm * tstepA + (unsigned)(((u).pn >> g.apn_shift) * g.apn_elems) * 2u)
#define PG8_UB(u) ((unsigned)(u).pn * tstepB)
    const char* const Ab = (const char*)g.A; const char* const Bb = (const char*)g.Bt;
    Unit cur, nxt; int ui = 0;
    if (!S.next(0, cur)) return;
    f32x4 acc[2][2][4][2];
#pragma unroll
    for (int a = 0; a < 2; ++a)
#pragma unroll
        for (int b = 0; b < 2; ++b)
#pragma unroll
            for (int m = 0; m < 4; ++m)
#pragma unroll
                for (int n = 0; n < 2; ++n) acc[a][b][m][n] = (f32x4){0.f, 0.f, 0.f, 0.f};
    bf16x8 At[4][2], B0[2][2], B1[2][2];
    unsigned cA = PG8_UA(cur), cB = PG8_UB(cur);
    PG8_STAGE(PG8_SB(0, 0), Bb, cB, voffB); PG8_STAGE(PG8_SB(0, 1), Bb, cB + hstepB, voffB); PG8_STAGE(PG8_SA(0, 0), Ab, cA, voffA); PG8_STAGE(PG8_SA(0, 1), Ab, cA + hstepA, voffA);
    if (wr == 1) PG8_BAR;
    PG8_WAIT_V(2); PG8_BAR;
    PG8_STAGE(PG8_SB(1, 0), Bb, cB + kstep, voffB); PG8_STAGE(PG8_SA(1, 0), Ab, cA + kstep, voffA); PG8_STAGE(PG8_SB(1, 1), Bb, cB + hstepB + kstep, voffB);
    PG8_WAIT_V(6); PG8_BAR;
    for (;;) {
        const bool has_next = S.next(ui + 1, nxt);
        const unsigned nA = has_next ? PG8_UA(nxt) : cA; const unsigned nB = has_next ? PG8_UB(nxt) : cB;
#pragma nounroll
        for (int t = 0; t < nt; t += 2) {
            const bool last = (t == nt - 2);
            const unsigned a1 = cA + (unsigned)(t + 1) * kstep;
            const unsigned a2 = last ? nA : cA + (unsigned)(t + 2) * kstep; const unsigned b2 = last ? nB : cB + (unsigned)(t + 2) * kstep;
            const unsigned a3 = a2 + kstep; const unsigned b3 = b2 + kstep;
            PG8_LDB(B0, 0, 0); PG8_LDB(B1, 0, 1); PG8_SCHED; PG8_LDA(At, 0, 0); PG8_STAGE(PG8_SA(1, 1), Ab, a1 + hstepA, voffA);
            PG8_WAIT_V(8); PG8_WAIT_L(0); PG8_BAR; PG8_MMA(0, 0, At, B0); PG8_MMA(0, 1, At, B1); PG8_BAR; PG8_SCHED;
            PG8_LDA(At, 0, 1); PG8_STAGE(PG8_SB(0, 0), Bb, b2, voffB); PG8_STAGE(PG8_SB(0, 1), Bb, b2 + hstepB, voffB); PG8_STAGE(PG8_SA(0, 0), Ab, a2, voffA);
            PG8_WAIT_V(8); PG8_WAIT_L(0); PG8_BAR; PG8_MMA(1, 0, At, B0); PG8_MMA(1, 1, At, B1); PG8_BAR; PG8_SCHED;
            PG8_LDB(B0, 1, 0); PG8_LDB(B1, 1, 1); PG8_SCHED; PG8_LDA(At, 1, 0); PG8_STAGE(PG8_SA(0, 1), Ab, a2 + hstepA, voffA);
            PG8_WAIT_V(8); PG8_WAIT_L(0); PG8_BAR; PG8_MMA(0, 0, At, B0); PG8_MMA(0, 1, At, B1); PG8_BAR; PG8_SCHED;
            PG8_LDA(At, 1, 1); PG8_STAGE(PG8_SB(1, 0), Bb, b3, voffB); PG8_STAGE(PG8_SB(1, 1), Bb, b3 + hstepB, voffB); PG8_STAGE(PG8_SA(1, 0), Ab, a3, voffA);
            PG8_WAIT_V(8); PG8_WAIT_L(0); PG8_BAR; PG8_MMA(1, 0, At, B0); PG8_MMA(1, 1, At, B1); PG8_BAR; PG8_SCHED;
        }
        if constexpr (ALIGN_EPI) { if (wr == 0) PG8_BAR; }
        E(acc, cur, wr, wc, fr, fq);
        if (!has_next) break;
#pragma unroll
        for (int a = 0; a < 2; ++a)
#pragma unroll
            for (int b = 0; b < 2; ++b)
#pragma unroll
                for (int m = 0; m < 4; ++m)
#pragma unroll
                    for (int n = 0; n < 2; ++n) acc[a][b][m][n] = (f32x4){0.f, 0.f, 0.f, 0.f};
        cur = nxt; cA = nA; cB = nB; ++ui;
        if constexpr (ALIGN_EPI) { if (wr == 1) PG8_BAR; }
    }
    PG8_WAIT_V(0);
    if constexpr (!ALIGN_EPI) { if (wr == 0) PG8_BAR; }
    PG8_BAR;
#undef PG8_SA
#undef PG8_SB
#undef PG8_STAGE
#undef PG8_LDA
#undef PG8_LDB
#undef PG8_MMA
#undef PG8_WAIT_V
#undef PG8_WAIT_L
#undef PG8_BAR
#undef PG8_SCHED
#undef PG8_UA
#undef PG8_UB
}
}

namespace att {
typedef short v4i16_t __attribute__((ext_vector_type(4)));
constexpr int KPITCH = 144;
constexpr int KTILE = 64 * KPITCH;
constexpr int VTILE = 8192;
constexpr int OFF_K = 0, OFF_V = 2 * KTILE, OFF_BIAS = OFF_V + 2 * VTILE, OFF_FLAG = OFF_BIAS + 2064, LDS_BYTES = OFF_FLAG + 64;
constexpr float SB_CUT = -104.0f;
__device__ __forceinline__ int crow(int r, int hi) { return (r & 3) + 8 * (r >> 2) + 4 * hi; }
__device__ __forceinline__ v4i16_t vtr(LAS const unsigned char* p) { return __builtin_amdgcn_ds_read_tr16_b64_v4i16((LAS v4i16_t*)p); }

template <int MODE>
__device__ __forceinline__ void unit(const bf16_t* __restrict__ qkv, bf16_t* __restrict__ O, int b, int h, int qb, const float* __restrict__ relb, LAS unsigned char* lds) {
    const int tid = threadIdx.x, lane = tid & 63, l32 = lane & 31, hi = lane >> 5; const int w = __builtin_amdgcn_readfirstlane(tid >> 6);
    constexpr int QOFF = MODE == 0 ? 0 : 1536, KOFF = QOFF + 512, VOFF = QOFF + 1024, OOFF = MODE == 0 ? 0 : 512;
    const size_t rowbase = (size_t)b * SEQ;
    const int T0 = qb * 256 + w * 32;
    const int cw = 4 * qb + (w >> 1);
    bf16x8 qf[4];
    { const bf16_t* qp = qkv + (rowbase + T0 + l32) * QKVW + QOFF + h * 64 + hi * 8;
#pragma unroll
      for (int d0 = 0; d0 < 4; ++d0) qf[d0] = *(const bf16x8*)(qp + d0 * 16); }
    const int t_hi = 4 * qb + 3, t_lo = MODE == 0 ? (4 * qb - 8 > 0 ? 4 * qb - 8 : 0) : 0;
    const int n = t_hi - t_lo + 1;
    const bf16_t* Kg = qkv + rowbase * QKVW + KOFF + h * 64 + (size_t)(tid >> 3) * QKVW + (tid & 7) * 8;
    const bf16_t* Vg = qkv + rowbase * QKVW + VOFF + h * 64 + (size_t)(tid >> 3) * QKVW + (tid & 7) * 8;
    const int kst = (tid >> 3) * KPITCH + (tid & 7) * 16;
    const int vst = ((tid & 7) >> 2) * 4096 + (tid >> 3) * 64 + (tid & 3) * 16;
    LAS float* biasl = (LAS float*)(lds + OFF_BIAS);
    LAS int* flags = (LAS int*)(lds + OFF_FLAG);
    if (MODE == 0) { for (int i = tid; i < 513; i += 512) biasl[i] = relb[i] * LOG2E; }
#define TILE_OF(i) (MODE == 0 ? t_lo + (i) : t_hi - (i))
    u32x4 kreg, vreg;
    { const int t0 = TILE_OF(0); kreg = *(const u32x4*)(Kg + (size_t)t0 * 64 * QKVW); vreg = *(const u32x4*)(Vg + (size_t)t0 * 64 * QKVW); }
    *(LAS u32x4*)(lds + OFF_K + kst) = kreg; *(LAS u32x4*)(lds + OFF_V + vst) = vreg;
    __syncthreads();
    f32x16 o0 = {}, o1 = {};
    float mrun = -INFINITY, lsum = 0.f, carry = 0.f;
    bool alive = true;
    const int kfr = l32 * KPITCH + hi * 16;
    const int vfr = (4 * hi + ((lane & 15) >> 2)) * 64 + ((lane >> 4) & 1) * 32 + (lane & 3) * 8;
    const int tq = T0 + l32;
    for (int i = 0; i < n; ++i) {
        const int tile = TILE_OF(i); const int buf = i & 1;
        const bool more = (i + 1 < n);
        if (more) { const int t1 = TILE_OF(i + 1); kreg = *(const u32x4*)(Kg + (size_t)t1 * 64 * QKVW); vreg = *(const u32x4*)(Vg + (size_t)t1 * 64 * QKVW); }
        const bool act = MODE == 0 ? (tile >= cw - 8 && tile <= cw) : (tile <= cw && alive);
        if (act) {
            f32x16 p[2];
            LAS const unsigned char* kb_ = lds + OFF_K + buf * KTILE + kfr;
#pragma unroll
            for (int kb = 0; kb < 2; ++kb) { f32x16 a = {};
#pragma unroll
                for (int d0 = 0; d0 < 4; ++d0) { const bf16x8 kf = *(const LAS bf16x8*)(kb_ + kb * 32 * KPITCH + d0 * 32); a = __builtin_amdgcn_mfma_f32_32x32x16_bf16(kf, qf[d0], a, 0, 0, 0); }
                p[kb] = a; }
            const int tk0 = tile * 64 + 4 * hi;
            if (MODE == 0) {
                float rm = -INFINITY;
                const int rel0 = tq - tk0;
                const bool far = (T0 - tile * 64 - 63 >= 256);
                if (far) { const float bb = biasl[512];
#pragma unroll
                    for (int kb = 0; kb < 2; ++kb)
#pragma unroll
                        for (int r = 0; r < 16; ++r) { const float s = p[kb][r] * (0.125f * LOG2E) + bb; p[kb][r] = s; rm = fmaxf(rm, s); }
                } else {
#pragma unroll
                    for (int kb = 0; kb < 2; ++kb)
#pragma unroll
                        for (int r = 0; r < 16; ++r) { int rel = rel0 - 32 * kb - (r & 3) - 8 * (r >> 2); rel = rel > 256 ? 256 : rel;
                            const float s = p[kb][r] * (0.125f * LOG2E) + biasl[rel + 256]; p[kb][r] = s; rm = fmaxf(rm, s); }
                }
                rm = fmaxf(rm, __shfl_xor(rm, 32));
                const float mnew = fmaxf(mrun, rm); const float alpha = __builtin_amdgcn_exp2f(mrun - mnew); mrun = mnew;
                float ps = 0.f;
#pragma unroll
                for (int kb = 0; kb < 2; ++kb)
#pragma unroll
                    for (int r = 0; r < 16; ++r) { const float e = __builtin_amdgcn_exp2f(p[kb][r] - mnew); p[kb][r] = e; ps += e; }
                lsum = lsum * alpha + ps;
#pragma unroll
                for (int r = 0; r < 16; ++r) { o0[r] *= alpha; o1[r] *= alpha; }
            } else {
                const bool diag = (tile == cw);
                f32x16 l1v[2]; float G[8];
#pragma unroll
                for (int kb = 0; kb < 2; ++kb)
#pragma unroll
                    for (int g = 0; g < 4; ++g) { float gs = 0.f;
#pragma unroll
                        for (int e = 0; e < 4; ++e) { const int r = 4 * g + e; const float z = p[kb][r] * 0.125f;
                            const float sp = __builtin_amdgcn_logf(1.0f + __builtin_amdgcn_exp2f(-fabsf(z) * LOG2E)) * 0.6931471805599453f;
                            float lb = fminf(z, 0.f) - sp; float l1 = lb - z;
                            if (diag) { const int tk = tk0 + 32 * kb + 8 * g + e; if (tk >= tq) { l1 = 0.f; lb = -INFINITY; } }
                            p[kb][r] = lb; l1v[kb][r] = l1; gs += l1; }
                        G[4 * kb + g] = gs; }
                float Gp[8];
#pragma unroll
                for (int k = 0; k < 8; ++k) Gp[k] = __shfl_xor(G[k], 32);
                float R = 0.f; float suf[8];
#pragma unroll
                for (int k = 7; k >= 0; --k) { suf[k] = R + (hi == 0 ? Gp[k] : 0.f); R += G[k] + Gp[k]; }
#pragma unroll
                for (int kb = 0; kb < 2; ++kb)
#pragma unroll
                    for (int g = 0; g < 4; ++g) { float run = carry + suf[4 * kb + g];
#pragma unroll
                        for (int e = 3; e >= 0; --e) { const int r = 4 * g + e; const float wgt = __builtin_amdgcn_exp2f((p[kb][r] + run) * LOG2E); run += l1v[kb][r]; p[kb][r] = wgt; } }
                carry += R;
                alive = __builtin_amdgcn_ballot_w64(carry > SB_CUT) != 0ull;
            }
            bf16x8 pf[4];
#pragma unroll
            for (int ks = 0; ks < 4; ++ks) { const int kb = ks >> 1, r0 = 8 * (ks & 1);
                u32x4 t; t.x = cvtpk(p[kb][r0], p[kb][r0 + 1]); t.y = cvtpk(p[kb][r0 + 2], p[kb][r0 + 3]); t.z = cvtpk(p[kb][r0 + 4], p[kb][r0 + 5]); t.w = cvtpk(p[kb][r0 + 6], p[kb][r0 + 7]);
                pf[ks] = __builtin_bit_cast(bf16x8, t); }
            LAS const unsigned char* vb_ = lds + OFF_V + buf * VTILE + vfr;
#pragma unroll
            for (int ks = 0; ks < 4; ++ks) {
                { const v4i16_t lo = vtr(vb_ + ks * 1024), up = vtr(vb_ + ks * 1024 + 512);
                  const bf16x8 vf = {lo[0], lo[1], lo[2], lo[3], up[0], up[1], up[2], up[3]};
                  o0 = __builtin_amdgcn_mfma_f32_32x32x16_bf16(vf, pf[ks], o0, 0, 0, 0); }
                { const v4i16_t lo = vtr(vb_ + 4096 + ks * 1024), up = vtr(vb_ + 4096 + ks * 1024 + 512);
                  const bf16x8 vf = {lo[0], lo[1], lo[2], lo[3], up[0], up[1], up[2], up[3]};
                  o1 = __builtin_amdgcn_mfma_f32_32x32x16_bf16(vf, pf[ks], o1, 0, 0, 0); }
            }
        }
        if (more) { *(LAS u32x4*)(lds + OFF_K + (buf ^ 1) * KTILE + kst) = kreg; *(LAS u32x4*)(lds + OFF_V + (buf ^ 1) * VTILE + vst) = vreg; }
        if (MODE == 1) { if (lane == 0) flags[buf * 8 + w] = alive ? 1 : 0; }
        __syncthreads();
        if (MODE == 1) { int any = 0;
#pragma unroll
            for (int k = 0; k < 8; ++k) any |= flags[buf * 8 + k];
            if (!any) break; }
    }
    float inv = 1.0f;
    if (MODE == 0) { const float l = lsum + __shfl_xor(lsum, 32); inv = 1.0f / l; }
    bf16_t* op = O + (rowbase + T0 + l32) * DM + OOFF + h * 64 + 4 * hi;
#pragma unroll
    for (int g4 = 0; g4 < 4; ++g4) {
        u32x2 a, c; a.x = cvtpk(o0[4 * g4] * inv, o0[4 * g4 + 1] * inv); a.y = cvtpk(o0[4 * g4 + 2] * inv, o0[4 * g4 + 3] * inv);
        c.x = cvtpk(o1[4 * g4] * inv, o1[4 * g4 + 1] * inv); c.y = cvtpk(o1[4 * g4 + 2] * inv, o1[4 * g4 + 3] * inv);
        *(u32x2*)(op + 8 * g4) = a; *(u32x2*)(op + 32 + 8 * g4) = c; }
#undef TILE_OF
}
}

constexpr size_t MiB = 1u << 20;
constexpr size_t WS_NSP = 1 * MiB;
constexpr size_t WS_W_ATT_IN = 2 * MiB;
constexpr size_t WS_W_ATT_OUT = 14 * MiB;
constexpr size_t WS_W_RG_IN = 18 * MiB;
constexpr size_t WS_W_RG_OUT = 26 * MiB;
constexpr size_t WS_W_RG_GATES = 30 * MiB;
constexpr size_t WS_W_GU = 32 * MiB;
constexpr size_t WS_W_DOWN = 76 * MiB;
constexpr size_t WS_SUMP = 98 * MiB, WS_SUMH = 99 * MiB;
constexpr size_t WS_S0 = 100 * MiB, WS_S1 = 132 * MiB, WS_S2 = 164 * MiB, WS_S3 = 196 * MiB, WS_END = 228 * MiB;

struct Args {
    const float* x; const float* attn_w_in; const float* attn_rel_bias; const float* attn_w_out; const float* rg_w_in; const float* rg_conv_w; const float* rg_conv_b;
    const float* rg_w_a; const float* rg_b_a; const float* rg_w_i; const float* rg_b_i; const float* rg_lambda; const float* rg_w_out;
    const float* norm_mix_pre; const float* norm_mix_post; const float* norm_ffn_pre; const float* norm_ffn_post;
    const float* ffn_w_gate; const float* ffn_w_up; const float* ffn_w_down;
    float* out; unsigned char* ws;
};

__device__ __forceinline__ unsigned long long karg_ld(int off) {
    auto kp = __builtin_amdgcn_kernarg_segment_ptr();
    unsigned long long r;
    asm volatile("s_load_dwordx2 %0, %1, %2\n\ts_waitcnt lgkmcnt(0)" : "=s"(r) : "s"(kp), "n"(off));
    return r;
}
#define KA(field) ((decltype(Args::field))karg_ld((int)__builtin_offsetof(Args, field)))
#define WSB(off) ((bf16_t*)(KA(ws) + (off)))
__device__ __forceinline__ float wave_sum(float v) {
#pragma unroll
    for (int o = 1; o < 64; o <<= 1) v += __shfl_xor(v, o);
    return v;
}
__device__ __forceinline__ void transpose_item(const float* __restrict__ W, int K, int N, bf16_t* __restrict__ WT, int base, bool inter, LAS float* scr, int item, int lane) {
    const int nblk = N / 32, kb = item / nblk, nb = item % nblk, k0 = 64 * kb, n0 = 32 * nb;
#pragma unroll 8
    for (int i = 0; i < 32; ++i) { const int kk = 2 * i + (lane >> 5); scr[kk * 33 + (lane & 31)] = W[(size_t)(k0 + kk) * N + n0 + (lane & 31)]; }
    asm volatile("s_waitcnt lgkmcnt(0)" ::: "memory");
    const int c = lane & 7;
    const int drow0 = base + (inter ? ((n0 >> 7) * 256 + (n0 & 127)) : n0);
#pragma unroll
    for (int j = 0; j < 4; ++j) { const int nn = (lane >> 3) + 8 * j; const LAS float* s = scr + (8 * c) * 33 + nn;
        u32x4 o; o.x = cvtpk(s[0 * 33], s[1 * 33]); o.y = cvtpk(s[2 * 33], s[3 * 33]); o.z = cvtpk(s[4 * 33], s[5 * 33]); o.w = cvtpk(s[6 * 33], s[7 * 33]);
        *(u32x4*)(WT + (size_t)(drow0 + nn) * K + k0 + 8 * c) = o; }
    asm volatile("s_waitcnt lgkmcnt(0)" ::: "memory");
}

__device__ __forceinline__ void rowpass(const float* xin, const bf16_t* mrow, const float* __restrict__ gpost, float* xout,
                                        const float* __restrict__ gpre, bf16_t* hout, int gw, int NGW, int lane) {
    f32x4 gp[4], gq[4];
#pragma unroll
    for (int j = 0; j < 4; ++j) { gp[j] = mrow ? ((const f32x4*)gpost)[lane + 64 * j] : (f32x4){0.f, 0.f, 0.f, 0.f}; gq[j] = gpre ? ((const f32x4*)gpre)[lane + 64 * j] : (f32x4){0.f, 0.f, 0.f, 0.f}; }
    for (int row = gw; row < M; row += NGW) {
        f32x4 v[4];
#pragma unroll
        for (int j = 0; j < 4; ++j) v[j] = ((const f32x4*)(xin + (size_t)row * DM))[lane + 64 * j];
        if (mrow) {
            f32x4 mv[4]; float s = 0.f;
#pragma unroll
            for (int j = 0; j < 4; ++j) { const u32x2 t = ((const u32x2*)(mrow + (size_t)row * DM))[lane + 64 * j]; mv[j] = (f32x4){bf_lo(t.x), bf_hi(t.x), bf_lo(t.y), bf_hi(t.y)};
                s += (mv[j].x * mv[j].x + mv[j].y * mv[j].y) + (mv[j].z * mv[j].z + mv[j].w * mv[j].w); }
            const float sc = 1.0f / sqrtf(wave_sum(s) * (1.0f / DM) + RMS_EPS);
#pragma unroll
            for (int j = 0; j < 4; ++j) v[j] = v[j] + mv[j] * sc * gp[j];
        }
        if (xout) {
#pragma unroll
            for (int j = 0; j < 4; ++j) ((f32x4*)(xout + (size_t)row * DM))[lane + 64 * j] = v[j];
        }
        if (gpre) {
            float s2 = 0.f;
#pragma unroll
            for (int j = 0; j < 4; ++j) s2 += (v[j].x * v[j].x + v[j].y * v[j].y) + (v[j].z * v[j].z + v[j].w * v[j].w);
            const float r = 1.0f / sqrtf(wave_sum(s2) * (1.0f / DM) + RMS_EPS);
#pragma unroll
            for (int j = 0; j < 4; ++j) { const f32x4 hv = v[j] * r * gq[j]; u32x2 t; t.x = cvtpk(hv.x, hv.y); t.y = cvtpk(hv.z, hv.w); ((u32x2*)(hout + (size_t)row * DM))[lane + 64 * j] = t; }
        }
    }
}

__device__ __forceinline__ void conv_phase(const bf16_t* __restrict__ xr, bf16_t* __restrict__ xc, const float* __restrict__ cw, const float* __restrict__ cbp, int gt, int nthr) {
    for (int it = gt; it < 1024 * 128; it += nthr) {
        const int cgp = it & 127, run = it >> 7, c0 = cgp * 8, r0 = run * 16;
        float cwt[4][8], cb[8];
#pragma unroll
        for (int t = 0; t < 4; ++t)
#pragma unroll
            for (int e = 0; e < 8; ++e) cwt[t][e] = cw[(size_t)t * DM + c0 + e];
#pragma unroll
        for (int e = 0; e < 8; ++e) cb[e] = cbp[c0 + e];
        float hst[3][8];
        const bool first = (r0 % SEQ) == 0;
#pragma unroll
        for (int t = 0; t < 3; ++t) { u32x4 q = {0u, 0u, 0u, 0u}; if (!first) q = *(const u32x4*)(xr + (size_t)(r0 - 3 + t) * DM + c0);
            hst[t][0] = bf_lo(q.x); hst[t][1] = bf_hi(q.x); hst[t][2] = bf_lo(q.y); hst[t][3] = bf_hi(q.y); hst[t][4] = bf_lo(q.z); hst[t][5] = bf_hi(q.z); hst[t][6] = bf_lo(q.w); hst[t][7] = bf_hi(q.w); }
#pragma unroll 4
        for (int r = 0; r < 16; ++r) {
            const u32x4 q = *(const u32x4*)(xr + (size_t)(r0 + r) * DM + c0);
            float cur[8] = {bf_lo(q.x), bf_hi(q.x), bf_lo(q.y), bf_hi(q.y), bf_lo(q.z), bf_hi(q.z), bf_lo(q.w), bf_hi(q.w)};
            float ov[8];
#pragma unroll
            for (int e = 0; e < 8; ++e) { ov[e] = cb[e] + cwt[0][e] * hst[0][e] + cwt[1][e] * hst[1][e] + cwt[2][e] * hst[2][e] + cwt[3][e] * cur[e];
                hst[0][e] = hst[1][e]; hst[1][e] = hst[2][e]; hst[2][e] = cur[e]; }
            u32x4 o; o.x = cvtpk(ov[0], ov[1]); o.y = cvtpk(ov[2], ov[3]); o.z = cvtpk(ov[4], ov[5]); o.w = cvtpk(ov[6], ov[7]);
            *(u32x4*)(xc + (size_t)(r0 + r) * DM + c0) = o;
        }
    }
}
__device__ __forceinline__ void scan1_phase(const bf16_t* __restrict__ LA, const bf16_t* __restrict__ U, float* __restrict__ sumP, float* __restrict__ sumH, int gt, int nthr) {
    for (int it = gt; it < 256 * 512; it += nthr) {
        const int cp = it & 511, ch = it >> 9; const size_t base = (size_t)ch * 64 * DM + cp * 2;
        float P0 = 1.f, P1 = 1.f, H0 = 0.f, H1 = 0.f;
#pragma unroll 8
        for (int r = 0; r < 64; ++r) { const unsigned la = *(const unsigned*)(LA + base + (size_t)r * DM), uu = *(const unsigned*)(U + base + (size_t)r * DM);
            const float a0 = fast_exp(bf_lo(la)), a1 = fast_exp(bf_hi(la));
            P0 *= a0; P1 *= a1; H0 = a0 * H0 + bf_lo(uu); H1 = a1 * H1 + bf_hi(uu); }
        *(f32x2*)(sumP + (size_t)ch * DM + cp * 2) = (f32x2){P0, P1}; *(f32x2*)(sumH + (size_t)ch * DM + cp * 2) = (f32x2){H0, H1};
    }
}
__device__ __forceinline__ void scan2_phase(const bf16_t* __restrict__ LA, const bf16_t* __restrict__ U, bf16_t* GT, const float* __restrict__ sumP, const float* __restrict__ sumH, int gt, int nthr) {
    for (int it = gt; it < 256 * 512; it += nthr) {
        const int cp = it & 511, ch = it >> 9, c = ch & 127, ch0 = ch - c; const size_t base = (size_t)ch * 64 * DM + cp * 2;
        float H0 = 0.f, H1 = 0.f;
#pragma unroll 8
        for (int k = 0; k < c; ++k) { const f32x2 p = *(const f32x2*)(sumP + (size_t)(ch0 + k) * DM + cp * 2), hh = *(const f32x2*)(sumH + (size_t)(ch0 + k) * DM + cp * 2);
            H0 = p.x * H0 + hh.x; H1 = p.y * H1 + hh.y; }
#pragma unroll 8
        for (int r = 0; r < 64; ++r) { const unsigned la = *(const unsigned*)(LA + base + (size_t)r * DM), uu = *(const unsigned*)(U + base + (size_t)r * DM), gg = *(const unsigned*)(GT + base + (size_t)r * DM);
            const float a0 = fast_exp(bf_lo(la)), a1 = fast_exp(bf_hi(la));
            H0 = a0 * H0 + bf_lo(uu); H1 = a1 * H1 + bf_hi(uu);
            *(unsigned*)(GT + base + (size_t)r * DM) = cvtpk(H0 * bf_lo(gg), H1 * bf_hi(gg)); }
    }
}

#ifndef PH
#define PH 0xffff
#endif
constexpr int NTHREADS = 512, NWAVES = 8;
constexpr int LDS_BYTES = 147456;

__global__ void __launch_bounds__(NTHREADS, 2) mega_fwd(Args a) {
    extern __shared__ __attribute__((aligned(16))) unsigned char lds_raw[];
    LAS unsigned char* lds = (LAS unsigned char*)lds_raw;
    cg::grid_group grid = cg::this_grid();
    const int tid = threadIdx.x, lane = tid & 63; const int wave = __builtin_amdgcn_readfirstlane(tid >> 6);
    const int G = gridDim.x, bx = blockIdx.x;
    const int vcu = (G % 8 == 0) ? (bx % 8) * (G / 8) + bx / 8 : bx;
    const int gw = vcu * NWAVES + wave, NGW = G * NWAVES;
#define S0 WSB(WS_S0)
#define S1 WSB(WS_S1)
#define S2 WSB(WS_S2)
#define S3 WSB(WS_S3)
#define WSP KA(ws)

    {
        LAS float* scr = (LAS float*)(lds + wave * 16384);
        unsigned char* const wsl = WSP;
        int off = 0;
        for (int job = 0; job < 36; ++job) {
            const float* W; int K, N, base = 0; bool inter = false; bf16_t* WT;
            if (job < 2) { W = KA(attn_w_in) + (size_t)job * DM * QKVW; K = DM; N = QKVW; WT = (bf16_t*)(wsl + WS_W_ATT_IN) + (size_t)job * QKVW * DM; }
            else if (job < 4) { const int j = job - 2; W = KA(attn_w_out) + (size_t)j * DM * DM; K = DM; N = DM; WT = (bf16_t*)(wsl + WS_W_ATT_OUT) + (size_t)j * DM * DM; }
            else if (job < 6) { const int j = job - 4; W = KA(rg_w_in) + (size_t)j * DM * 2048; K = DM; N = 2048; WT = (bf16_t*)(wsl + WS_W_RG_IN) + (size_t)j * 2048 * DM; }
            else if (job < 8) { const int j = job - 6; W = KA(rg_w_out) + (size_t)j * DM * DM; K = DM; N = DM; WT = (bf16_t*)(wsl + WS_W_RG_OUT) + (size_t)j * DM * DM; }
            else if (job < 24) { const int idx = job - 8, j = idx >> 3, which = (idx >> 2) & 1, blk = idx & 3;
                W = (which ? KA(rg_w_i) : KA(rg_w_a)) + (size_t)(j * 4 + blk) * 65536; K = 256; N = 256; WT = (bf16_t*)(wsl + WS_W_RG_GATES) + (size_t)j * 2048 * 256; base = blk * 512 + which * 128; inter = true; }
            else if (job < 28) { const int l = job - 24; W = KA(ffn_w_gate) + (size_t)l * DM * DFF; K = DM; N = DFF; WT = (bf16_t*)(wsl + WS_W_GU) + (size_t)l * 2 * DFF * DM; base = 0; inter = true; }
            else if (job < 32) { const int l = job - 28; W = KA(ffn_w_up) + (size_t)l * DM * DFF; K = DM; N = DFF; WT = (bf16_t*)(wsl + WS_W_GU) + (size_t)l * 2 * DFF * DM; base = 128; inter = true; }
            else { const int l = job - 32; W = KA(ffn_w_down) + (size_t)l * DFF * DM; K = DFF; N = DM; WT = (bf16_t*)(wsl + WS_W_DOWN) + (size_t)l * DM * DFF; }
            const int nitems = (K / 64) * (N / 32);
            int first = gw - off; first %= NGW; if (first < 0) first += NGW;
            for (int it = first; it < nitems; it += NGW) transpose_item(W, K, N, WT, base, inter, scr, it, lane);
            off = (off + nitems) % NGW;
        }
    }
    { float* cst = (float*)(WSP + WS_NSP); const int gt = vcu * NTHREADS + tid; if (gt < 2 * DM) { const int jj = gt >> 10, c = gt & 1023;
        cst[jj * 3072 + c] = KA(rg_b_a)[gt]; cst[jj * 3072 + 1024 + c] = KA(rg_b_i)[gt]; cst[jj * 3072 + 2048 + c] = -8.0f * log1pf(expf(-KA(rg_lambda)[gt])); } }
    grid.sync();

    for (int step = 0; step <= DEPTH * 10; ++step) {
        const int layer = step / 10, sub = step - layer * 10, j = layer >> 1; const bool is_attn = (layer & 1) == 0, fin = (step == DEPTH * 10);
        if (!fin && is_attn && (sub == 3 || sub == 4 || sub == 5)) continue;
        if (fin || sub == 0 || sub == 7) {
            const float* xin; const bf16_t* mrow; const float* gpost; float* xout; const float* gpre; bf16_t* hout = S0;
            if (fin) { xin = KA(out); mrow = S0; gpost = KA(norm_ffn_post) + (size_t)(DEPTH - 1) * DM; xout = KA(out); gpre = nullptr; hout = nullptr; }
            else if (sub == 0) {
                if (layer == 0) { xin = KA(x); mrow = nullptr; gpost = nullptr; xout = nullptr; }
                else { xin = KA(out); mrow = S0; gpost = KA(norm_ffn_post) + (size_t)(layer - 1) * DM; xout = KA(out); }
                gpre = KA(norm_mix_pre) + (size_t)layer * DM;
            } else { xin = (layer == 0) ? KA(x) : KA(out); mrow = is_attn ? S1 : S2; gpost = KA(norm_mix_post) + (size_t)layer * DM; xout = KA(out); gpre = KA(norm_ffn_pre) + (size_t)layer * DM; }
            rowpass(xin, mrow, gpost, xout, gpre, hout, gw, NGW, lane);
        } else if (sub == 1 || sub == 3 || sub == 6 || sub == 8 || sub == 9) {
            unsigned oA, oB, oP0, oP1 = 0; int N, K = DM, lda = DM, ldb = DM, ash = 0, ael = 0, mode = pg8::EPI_STORE, ldc = DM;
            if (sub == 1) { oA = WS_S0; if (is_attn) { oB = WS_W_ATT_IN + j * (QKVW * DM * 2); N = QKVW; oP0 = WS_S1; ldc = QKVW; }
                            else { oB = WS_W_RG_IN + j * (2048 * DM * 2); N = 2048; mode = pg8::EPI_RECIN; oP0 = WS_S1; oP1 = WS_S2; } }
            else if (sub == 3) { oA = WS_S3; oB = WS_W_RG_GATES + j * (2048 * 256 * 2); N = 2048; K = 256; ldb = 256; ash = 1; ael = 256; mode = pg8::EPI_GATES; oP0 = 0; oP1 = WS_NSP + j * (3072 * 4); }
            else if (sub == 6) { N = DM; if (is_attn) { oA = WS_S0; oB = WS_W_ATT_OUT + j * (DM * DM * 2); oP0 = WS_S1; } else { oA = WS_S1; oB = WS_W_RG_OUT + j * (DM * DM * 2); oP0 = WS_S2; } }
            else if (sub == 8) { oA = WS_S0; oB = WS_W_GU + layer * (2 * DFF * DM * 2); N = 2 * DFF; mode = pg8::EPI_SWIGLU; oP0 = WS_S1; ldc = DFF; }
            else { oA = WS_S1; oB = WS_W_DOWN + layer * (DM * DFF * 2); N = DM; K = DFF; lda = DFF; ldb = DFF; oP0 = WS_S0; }
            unsigned char* const wsl = WSP;
            pg8::Gemm g{(const bf16_t*)(wsl + oA), (const bf16_t*)(wsl + oB), K, lda, ldb, ash, ael}; pg8::StaticOrder S; S.init(M, N, G, bx);
            pg8::Epi E{mode, wsl + oP0, wsl + oP1, ldc};
            pg8::gemm_phase<true>(lds, g, S, E);
        } else if (sub == 2) {
            if (is_attn) {
                for (int uu = vcu; uu < 1024; uu += G) {
                    const int uidx = uu & 511;
                    const int qb = uidx & 31, hh = (uidx >> 5) & 7, bb = uidx >> 8;
                    if (uu < 512) att::unit<0>(S1, S0, bb, hh, qb, KA(attn_rel_bias) + (size_t)(j * 8 + hh) * 513, lds);
                    else att::unit<1>(S1, S0, bb, hh, qb, nullptr, lds);
                }
            } else conv_phase(S2, S3, KA(rg_conv_w) + (size_t)j * 4 * DM, KA(rg_conv_b) + (size_t)j * DM, vcu * NTHREADS + tid, G * NTHREADS);
        } else if (sub == 4) scan1_phase(S2, S0, (float*)(WSP + WS_SUMP), (float*)(WSP + WS_SUMH), vcu * NTHREADS + tid, G * NTHREADS);
        else scan2_phase(S2, S0, S1, (const float*)(WSP + WS_SUMP), (const float*)(WSP + WS_SUMH), vcu * NTHREADS + tid, G * NTHREADS);
        if (!fin) grid.sync();
    }
}

#undef WSP
#undef S0
#undef S1
#undef S2
#undef S3
extern "C" void kernel_launch(void* const* d_in, const int* in_sizes, int n_in, void* d_out, int out_size, void* d_ws, size_t ws_size, hipStream_t stream) {
    static int grid = 0;
    if (grid == 0) {
        if (n_in != 20 || in_sizes[0] != M * DM || out_size != M * DM || ws_size < WS_END) { fprintf(stderr, "kernel_launch: unexpected shapes (n_in %d, in0 %d, out %d, ws %zu); nothing launched\n", n_in, n_in > 0 ? in_sizes[0] : -1, out_size, ws_size); grid = -1; return; }
        int dev = 0, cus = 0, per_cu = 0;
        if (hipGetDevice(&dev) != hipSuccess || hipDeviceGetAttribute(&cus, hipDeviceAttributeMultiprocessorCount, dev) != hipSuccess) { grid = -1; return; }
        if (hipFuncSetAttribute((const void*)mega_fwd, hipFuncAttributeMaxDynamicSharedMemorySize, LDS_BYTES) != hipSuccess) { fprintf(stderr, "kernel_launch: hipFuncSetAttribute failed\n"); grid = -1; return; }
        if (hipOccupancyMaxActiveBlocksPerMultiprocessor(&per_cu, (const void*)mega_fwd, NTHREADS, LDS_BYTES) != hipSuccess || per_cu < 1) { fprintf(stderr, "kernel_launch: occupancy query says %d\n", per_cu); per_cu = 1; }
        (void)hipGetLastError();
        grid = cus * 1;
    }
    if (grid < 0) return;
    Args a{};
    a.x = (const float*)d_in[0]; a.attn_w_in = (const float*)d_in[1]; a.attn_rel_bias = (const float*)d_in[2]; a.attn_w_out = (const float*)d_in[3];
    a.rg_w_in = (const float*)d_in[4]; a.rg_conv_w = (const float*)d_in[5]; a.rg_conv_b = (const float*)d_in[6]; a.rg_w_a = (const float*)d_in[7]; a.rg_b_a = (const float*)d_in[8];
    a.rg_w_i = (const float*)d_in[9]; a.rg_b_i = (const float*)d_in[10]; a.rg_lambda = (const float*)d_in[11]; a.rg_w_out = (const float*)d_in[12];
    a.norm_mix_pre = (const float*)d_in[13]; a.norm_mix_post = (const float*)d_in[14]; a.norm_ffn_pre = (const float*)d_in[15]; a.norm_ffn_post = (const float*)d_in[16];
    a.ffn_w_gate = (const float*)d_in[17]; a.ffn_w_up = (const float*)d_in[18]; a.ffn_w_down = (const float*)d_in[19];
    a.out = (float*)d_out; a.ws = (unsigned char*)d_ws;
    void* args[] = {&a};
    hipError_t e = hipLaunchCooperativeKernel((const void*)mega_fwd, dim3(grid), dim3(NTHREADS), args, LDS_BYTES, stream);
    if (e != hipSuccess) fprintf(stderr, "kernel_launch: cooperative launch failed: %s (grid %d)\n", hipGetErrorString(e), grid);
}
```

```cpp
#include <hip/hip_runtime.h>
#include <hip/hip_cooperative_groups.h>
#include <cstdio>
#include <cstdint>
namespace cg = cooperative_groups;

#define LAS __attribute__((address_space(3)))
typedef unsigned short bf16_t;
typedef short bf16x8 __attribute__((ext_vector_type(8)));
typedef float f32x4 __attribute__((ext_vector_type(4)));
typedef float f32x2 __attribute__((ext_vector_type(2)));
typedef float f32x16 __attribute__((ext_vector_type(16)));
typedef unsigned u32x4 __attribute__((ext_vector_type(4)));
typedef unsigned u32x2 __attribute__((ext_vector_type(2)));
typedef __bf16 bf16x2_t __attribute__((ext_vector_type(2)));

constexpr int BATCH = 2, SEQ = 8192, DM = 1024, DEPTH = 4, M = BATCH * SEQ;
constexpr int DFF = 2816, QKVW = 3072;
constexpr float RMS_EPS = 1e-6f;
constexpr float LOG2E = 1.4426950408889634f;

__device__ __forceinline__ unsigned cvtpk(float lo, float hi) { f32x2 v = {lo, hi}; bf16x2_t b = __builtin_convertvector(v, bf16x2_t); return __builtin_bit_cast(unsigned, b); }
__device__ __forceinline__ float bf_lo(unsigned w) { return __uint_as_float(w << 16); }
__device__ __forceinline__ float bf_hi(unsigned w) { return __uint_as_float(w & 0xffff0000u); }
__device__ __forceinline__ float fast_exp(float x) { return __builtin_amdgcn_exp2f(x * LOG2E); }
__device__ __forceinline__ float fast_sigmoid(float x) { return __builtin_amdgcn_rcpf(1.0f + fast_exp(-x)); }
__device__ __forceinline__ float silu_f(float x) { return x * fast_sigmoid(x); }
__device__ __forceinline__ float gelu_tanh_f(float x) { const float t = 1.5957691216057308f * (x + 0.044715f * x * x * x); return x * fast_sigmoid(t); }

namespace pg8 {
constexpr int BM = 256, BK = 64, HALF = 128, HTB = HALF * BK * 2, STAGE_BYTES = 8 * HTB, NXCD = 8, WGM = 8;

__host__ __device__ __forceinline__ int lds_byte(int r, int c) { const int st = (r >> 4) * 2 + (c >> 5), rr = r & 15, cc = c & 31, ob = rr * 64 + cc * 2; return st * 1024 + (ob ^ (((ob >> 9) & 1) << 5)); }
__host__ __device__ __forceinline__ void stage_rc(int b, int& R, int& C) { const int st = b / 1024, sb = b % 1024, swz = sb ^ (((sb >> 9) & 1) << 5); R = (st >> 1) * 16 + swz / 64; C = (st & 1) * 32 + (swz % 64) / 2; }
__host__ __device__ __forceinline__ int perm32(int rho) { const int n = rho >> 4, i = rho & 15; return 8 * (i >> 2) + 4 * n + (i & 3); }

struct Unit { int pm, pn; };
struct Gemm { const bf16_t* A; const bf16_t* Bt; int K, lda, ldb, apn_shift, apn_elems; };

struct StaticOrder {
    int nM, nN, nwg, G, c;
    __host__ __device__ void init(int M_, int N_, int G_, int c_) { nM = M_ / BM; nN = N_ / BM; nwg = nM * nN; G = G_; c = c_; }
    __host__ __device__ bool next(int i, Unit& u) const {
        const long L = (long)i * G + c; if (L >= nwg) return false;
        int wgid = (int)L; { const int q = nwg / NXCD, r = nwg % NXCD, xcd = wgid % NXCD, off = wgid / NXCD; wgid = (xcd < r ? xcd * (q + 1) : r * (q + 1) + (xcd - r) * q) + off; }
        const int nig = WGM * nN, gid = wgid / nig, fm = gid * WGM, gsz = (nM - fm) < WGM ? (nM - fm) : WGM;
        u.pm = fm + ((wgid % nig) % gsz); u.pn = (wgid % nig) / gsz; return true;
    }
};

enum { EPI_STORE = 0, EPI_SWIGLU = 1, EPI_RECIN = 2, EPI_GATES = 3 };

struct Epi {
    int mode; unsigned char* p0; unsigned char* p1; int ldc;
    __device__ __forceinline__ void operator()(const f32x4 (&acc)[2][2][4][2], const Unit& u, int wr, int wc, int fr, int fq) const {
        const int row0 = u.pm * BM + wr * 64 + fr;
        if (mode == EPI_STORE) {
            bf16_t* O = (bf16_t*)p0; const int col0 = u.pn * BM + wc * 32 + 8 * fq;
#pragma unroll
            for (int ai = 0; ai < 2; ++ai)
#pragma unroll
                for (int m = 0; m < 4; ++m) { bf16_t* rowp = O + (size_t)(row0 + ai * HALF + m * 16) * ldc + col0;
#pragma unroll
                    for (int bj = 0; bj < 2; ++bj) { const f32x4 v0 = acc[ai][bj][m][0], v1 = acc[ai][bj][m][1];
                        u32x4 w; w.x = cvtpk(v0[0], v0[1]); w.y = cvtpk(v0[2], v0[3]); w.z = cvtpk(v1[0], v1[1]); w.w = cvtpk(v1[2], v1[3]);
                        *(u32x4*)(rowp + bj * HALF) = w; } }
        } else if (mode == EPI_SWIGLU) {
            bf16_t* O = (bf16_t*)p0; const int col0 = u.pn * HALF + wc * 32 + 8 * fq;
#pragma unroll
            for (int ai = 0; ai < 2; ++ai)
#pragma unroll
                for (int m = 0; m < 4; ++m) { bf16_t* rowp = O + (size_t)(row0 + ai * HALF + m * 16) * ldc + col0;
                    const f32x4 g0 = acc[ai][0][m][0], g1 = acc[ai][0][m][1], u0 = acc[ai][1][m][0], u1 = acc[ai][1][m][1];
                    u32x4 w; w.x = cvtpk(silu_f(g0[0]) * u0[0], silu_f(g0[1]) * u0[1]); w.y = cvtpk(silu_f(g0[2]) * u0[2], silu_f(g0[3]) * u0[3]);
                    w.z = cvtpk(silu_f(g1[0]) * u1[0], silu_f(g1[1]) * u1[1]); w.w = cvtpk(silu_f(g1[2]) * u1[2], silu_f(g1[3]) * u1[3]);
                    *(u32x4*)rowp = w; }
        } else if (mode == EPI_RECIN) {
            const bool isg = u.pn < 4; bf16_t* base = (bf16_t*)(isg ? p0 : p1);
            const int col0 = (u.pn & 3) * BM + wc * 32 + 8 * fq;
#pragma unroll
            for (int ai = 0; ai < 2; ++ai)
#pragma unroll
                for (int m = 0; m < 4; ++m) { bf16_t* rowp = base + (size_t)(row0 + ai * HALF + m * 16) * DM + col0;
#pragma unroll
                    for (int bj = 0; bj < 2; ++bj) { f32x4 v0 = acc[ai][bj][m][0], v1 = acc[ai][bj][m][1];
                        if (isg) {
#pragma unroll
                            for (int e = 0; e < 4; ++e) { v0[e] = gelu_tanh_f(v0[e]); v1[e] = gelu_tanh_f(v1[e]); } }
                        u32x4 w; w.x = cvtpk(v0[0], v0[1]); w.y = cvtpk(v0[2], v0[3]); w.z = cvtpk(v1[0], v1[1]); w.w = cvtpk(v1[2], v1[3]);
                        *(u32x4*)(rowp + bj * HALF) = w; } }
        } else {
            const int ch0 = u.pn * HALF + wc * 32 + 8 * fq; const float* cst = (const float*)p1;
            const bf16_t* XC = (const bf16_t*)(p0 + (196u << 20)); bf16_t* LA = (bf16_t*)(p0 + (164u << 20)); bf16_t* U = (bf16_t*)(p0 + (100u << 20));
#pragma unroll
            for (int n = 0; n < 2; ++n) {
                const f32x4 vba = *(const f32x4*)(cst + ch0 + 4 * n), vbi = *(const f32x4*)(cst + 1024 + ch0 + 4 * n), nsp = *(const f32x4*)(cst + 2048 + ch0 + 4 * n);
#pragma unroll
                for (int ai = 0; ai < 2; ++ai)
#pragma unroll
                    for (int m = 0; m < 4; ++m) { const size_t off = (size_t)(row0 + ai * HALF + m * 16) * DM + ch0 + 4 * n;
                        const u32x2 xw = *(const u32x2*)(XC + off);
                        const float xc[4] = {bf_lo(xw.x), bf_hi(xw.x), bf_lo(xw.y), bf_hi(xw.y)};
                        float la[4], uu[4];
#pragma unroll
                        for (int e = 0; e < 4; ++e) { const float pa = acc[ai][0][m][n][e] + vba[e], pi = acc[ai][1][m][n][e] + vbi[e];
                            const float r = fast_sigmoid(pa), ig = fast_sigmoid(pi);
                            la[e] = nsp[e] * r;
                            const float x2 = 2.0f * la[e];
                            const float ser = -x2 * (1.0f + x2 * (0.5f + x2 * (0.16666667f + x2 * (0.041666668f + x2 * (0.008333334f + x2 * (0.0013888889f + x2 * 0.0001984127f))))));
                            const float om = x2 > -0.3f ? ser : 1.0f - fast_exp(x2);
                            uu[e] = __builtin_amdgcn_sqrtf(om) * ig * xc[e]; }
                        u32x2 w1, w2; w1.x = cvtpk(la[0], la[1]); w1.y = cvtpk(la[2], la[3]); w2.x = cvtpk(uu[0], uu[1]); w2.y = cvtpk(uu[2], uu[3]);
                        *(u32x2*)(LA + off) = w1; *(u32x2*)(U + off) = w2;
                        asm volatile("" ::: "memory"); }
            }
        }
    }
};

template <bool ALIGN_EPI>
__device__ __forceinline__ void gemm_phase(LAS unsigned char* lds, const Gemm g, const StaticOrder& S, const Epi& E) {
    const int tid = threadIdx.x, wid = __builtin_amdgcn_readfirstlane(tid >> 6), lane = tid & 63, wr = wid >> 2, wc = wid & 3, fr = lane & 15, fq = lane >> 4;
    const int K = g.K, nt = K / BK;
    unsigned voffA[2], voffB[2];
#pragma unroll
    for (int i = 0; i < 2; ++i) { int R, C; stage_rc(tid * 16 + i * 8192, R, C); const int Rb = (R & ~31) + perm32(R & 31);
        voffA[i] = (unsigned)(R * g.lda + C) * 2u; voffB[i] = (unsigned)(Rb * g.ldb + C) * 2u; }
    constexpr unsigned kstep = BK * 2;
    const unsigned hstepA = (unsigned)(HALF * g.lda * 2), hstepB = (unsigned)(HALF * g.ldb * 2);
    const unsigned tstepA = 2 * hstepA, tstepB = 2 * hstepB;
    const unsigned ldsw = (unsigned)wid * 1024u;
    const int aoff = lds_byte(wr * 64 + fr, fq * 8), boff = lds_byte(wc * 32 + fr, fq * 8);
#define PG8_SA(b, h) (((b) * 2 + (h)) * HTB)
#define PG8_SB(b, h) ((4 + (b) * 2 + (h)) * HTB)
#define PG8_STAGE(bufoff, gbase, soff, voff) do { _Pragma("unroll") for (int _i = 0; _i < 2; ++_i) \
        __builtin_amdgcn_global_load_lds((const unsigned*)((gbase) + (size_t)(unsigned)((soff) + (voff)[_i])), (LAS unsigned*)(lds + (bufoff) + ldsw + _i * 8192), 16, 0, 0); } while (0)
#define PG8_LDA(dst, b, h) do { _Pragma("unroll") for (int m = 0; m < 4; ++m) _Pragma("unroll") for (int k = 0; k < 2; ++k) dst[m][k] = *(const LAS bf16x8*)(lds + PG8_SA(b, h) + aoff + m * 2048 + k * 1024); } while (0)
#define PG8_LDB(dst, b, h) do { _Pragma("unroll") for (int n = 0; n < 2; ++n) _Pragma("unroll") for (int k = 0; k < 2; ++k) dst[n][k] = *(const LAS bf16x8*)(lds + PG8_SB(b, h) + boff + n * 2048 + k * 1024); } while (0)
#define PG8_MMA(ai, bj, At, Bt) do { __builtin_amdgcn_s_setprio(1); _Pragma("unroll") for (int m = 0; m < 4; ++m) _Pragma("unroll") for (int n = 0; n < 2; ++n) _Pragma("unroll") for (int k = 0; k < 2; ++k) \
        acc[ai][bj][m][n] = __builtin_amdgcn_mfma_f32_16x16x32_bf16(Bt[n][k], At[m][k], acc[ai][bj][m][n], 0, 0, 0); __builtin_amdgcn_s_setprio(0); } while (0)
#define PG8_WAIT_V(n) asm volatile("s_waitcnt vmcnt(" #n ")" ::: "memory")
#define PG8_WAIT_L(n) asm volatile("s_waitcnt lgkmcnt(" #n ")" ::: "memory")
#define PG8_BAR __builtin_amdgcn_s_barrier()
#define PG8_SCHED __builtin_amdgcn_sched_barrier(0)
#define PG8_UA(u) ((unsigned)(u).pm * tstepA + (unsigned)(((u).pn >> g.apn_shift) * g.apn_elems) * 2u)
#define PG8_UB(u) ((unsigned)(u).pn * tstepB)
    const char* const Ab = (const char*)g.A; const char* const Bb = (const char*)g.Bt;
    Unit cur, nxt; int ui = 0;
    if (!S.next(0, cur)) return;
    f32x4 acc[2][2][4][2];
#pragma unroll
    for (int a = 0; a < 2; ++a)
#pragma unroll
        for (int b = 0; b < 2; ++b)
#pragma unroll
            for (int m = 0; m < 4; ++m)
#pragma unroll
                for (int n = 0; n < 2; ++n) acc[a][b][m][n] = (f32x4){0.f, 0.f, 0.f, 0.f};
    bf16x8 At[4][2], B0[2][2], B1[2][2];
    unsigned cA = PG8_UA(cur), cB = PG8_UB(cur);
    PG8_STAGE(PG8_SB(0, 0), Bb, cB, voffB); PG8_STAGE(PG8_SB(0, 1), Bb, cB + hstepB, voffB); PG8_STAGE(PG8_SA(0, 0), Ab, cA, voffA); PG8_STAGE(PG8_SA(0, 1), Ab, cA + hstepA, voffA);
    if (wr == 1) PG8_BAR;
    PG8_WAIT_V(2); PG8_BAR;
    PG8_STAGE(PG8_SB(1, 0), Bb, cB + kstep, voffB); PG8_STAGE(PG8_SA(1, 0), Ab, cA + kstep, voffA); PG8_STAGE(PG8_SB(1, 1), Bb, cB + hstepB + kstep, voffB);
    PG8_WAIT_V(6); PG8_BAR;
    for (;;) {
        const bool has_next = S.next(ui + 1, nxt);
        const unsigned nA = has_next ? PG8_UA(nxt) : cA; const unsigned nB = has_next ? PG8_UB(nxt) : cB;
#pragma nounroll
        for (int t = 0; t < nt; t += 2) {
            const bool last = (t == nt - 2);
            const unsigned a1 = cA + (unsigned)(t + 1) * kstep;
            const unsigned a2 = last ? nA : cA + (unsigned)(t + 2) * kstep; const unsigned b2 = last ? nB : cB + (unsigned)(t + 2) * kstep;
            const unsigned a3 = a2 + kstep; const unsigned b3 = b2 + kstep;
            PG8_LDB(B0, 0, 0); PG8_LDB(B1, 0, 1); PG8_SCHED; PG8_LDA(At, 0, 0); PG8_STAGE(PG8_SA(1, 1), Ab, a1 + hstepA, voffA);
            PG8_WAIT_V(8); PG8_WAIT_L(0); PG8_BAR; PG8_MMA(0, 0, At, B0); PG8_MMA(0, 1, At, B1); PG8_BAR; PG8_SCHED;
            PG8_LDA(At, 0, 1); PG8_STAGE(PG8_SB(0, 0), Bb, b2, voffB); PG8_STAGE(PG8_SB(0, 1), Bb, b2 + hstepB, voffB); PG8_STAGE(PG8_SA(0, 0), Ab, a2, voffA);
            PG8_WAIT_V(8); PG8_WAIT_L(0); PG8_BAR; PG8_MMA(1, 0, At, B0); PG8_MMA(1, 1, At, B1); PG8_BAR; PG8_SCHED;
            PG8_LDB(B0, 1, 0); PG8_LDB(B1, 1, 1); PG8_SCHED; PG8_LDA(At, 1, 0); PG8_STAGE(PG8_SA(0, 1), Ab, a2 + hstepA, voffA);
            PG8_WAIT_V(8); PG8_WAIT_L(0); PG8_BAR; PG8_MMA(0, 0, At, B0); PG8_MMA(0, 1, At, B1); PG8_BAR; PG8_SCHED;
            PG8_LDA(At, 1, 1); PG8_STAGE(PG8_SB(1, 0), Bb, b3, voffB); PG8_STAGE(PG8_SB(1, 1), Bb, b3 + hstepB, voffB); PG8_STAGE(PG8_SA(1, 0), Ab, a3, voffA);
            PG8_WAIT_V(8); PG8_WAIT_L(0); PG8_BAR; PG8_MMA(1, 0, At, B0); PG8_MMA(1, 1, At, B1); PG8_BAR; PG8_SCHED;
        }
        if constexpr (ALIGN_EPI) { if (wr == 0) PG8_BAR; }
        E(acc, cur, wr, wc, fr, fq);
        if (!has_next) break;
#pragma unroll
        for (int a = 0; a < 2; ++a)
#pragma unroll
            for (int b = 0; b < 2; ++b)
#pragma unroll
                for (int m = 0; m < 4; ++m)
#pragma unroll
                    for (int n = 0; n < 2; ++n) acc[a][b][m][n] = (f32x4){0.f, 0.f, 0.f, 0.f};
        cur = nxt; cA = nA; cB = nB; ++ui;
        if constexpr (ALIGN_EPI) { if (wr == 1) PG8_BAR; }
    }
    PG8_WAIT_V(0);
    if constexpr (!ALIGN_EPI) { if (wr == 0) PG8_BAR; }
    PG8_BAR;
#undef PG8_SA
#undef PG8_SB
#undef PG8_STAGE
#undef PG8_LDA
#undef PG8_LDB
#undef PG8_MMA
#undef PG8_WAIT_V
#undef PG8_WAIT_L
#undef PG8_BAR
#undef PG8_SCHED
#undef PG8_UA
#undef PG8_UB
}
}

namespace att {
typedef short v4i16_t __attribute__((ext_vector_type(4)));
constexpr int KPITCH = 144;
constexpr int KTILE = 64 * KPITCH;
constexpr int VTILE = 8192;
constexpr int OFF_K = 0, OFF_V = 2 * KTILE, OFF_BIAS = OFF_V + 2 * VTILE, OFF_FLAG = OFF_BIAS + 2064, LDS_BYTES = OFF_FLAG + 64;
constexpr float SB_CUT = -104.0f;
__device__ __forceinline__ int crow(int r, int hi) { return (r & 3) + 8 * (r >> 2) + 4 * hi; }
__device__ __forceinline__ v4i16_t vtr(LAS const unsigned char* p) { return __builtin_amdgcn_ds_read_tr16_b64_v4i16((LAS v4i16_t*)p); }

template <int MODE>
__device__ __forceinline__ void unit(const bf16_t* __restrict__ qkv, bf16_t* __restrict__ O, int b, int h, int qb, const float* __restrict__ relb, LAS unsigned char* lds) {
    const int tid = threadIdx.x, lane = tid & 63, l32 = lane & 31, hi = lane >> 5; const int w = __builtin_amdgcn_readfirstlane(tid >> 6);
    constexpr int QOFF = MODE == 0 ? 0 : 1536, KOFF = QOFF + 512, VOFF = QOFF + 1024, OOFF = MODE == 0 ? 0 : 512;
    const size_t rowbase = (size_t)b * SEQ;
    const int T0 = qb * 256 + w * 32;
    const int cw = 4 * qb + (w >> 1);
    bf16x8 qf[4];
    { const bf16_t* qp = qkv + (rowbase + T0 + l32) * QKVW + QOFF + h * 64 + hi * 8;
#pragma unroll
      for (int d0 = 0; d0 < 4; ++d0) qf[d0] = *(const bf16x8*)(qp + d0 * 16); }
    const int t_hi = 4 * qb + 3, t_lo = MODE == 0 ? (4 * qb - 8 > 0 ? 4 * qb - 8 : 0) : 0;
    const int n = t_hi - t_lo + 1;
    const bf16_t* Kg = qkv + rowbase * QKVW + KOFF + h * 64 + (size_t)(tid >> 3) * QKVW + (tid & 7) * 8;
    const bf16_t* Vg = qkv + rowbase * QKVW + VOFF + h * 64 + (size_t)(tid >> 3) * QKVW + (tid & 7) * 8;
    const int kst = (tid >> 3) * KPITCH + (tid & 7) * 16;
    const int vst = ((tid & 7) >> 2) * 4096 + (tid >> 3) * 64 + (tid & 3) * 16;
    LAS float* biasl = (LAS float*)(lds + OFF_BIAS);
    LAS int* flags = (LAS int*)(lds + OFF_FLAG);
    if (MODE == 0) { for (int i = tid; i < 513; i += 512) biasl[i] = relb[i] * LOG2E; }
#define TILE_OF(i) (MODE == 0 ? t_lo + (i) : t_hi - (i))
    u32x4 kreg, vreg;
    { const int t0 = TILE_OF(0); kreg = *(const u32x4*)(Kg + (size_t)t0 * 64 * QKVW); vreg = *(const u32x4*)(Vg + (size_t)t0 * 64 * QKVW); }
    *(LAS u32x4*)(lds + OFF_K + kst) = kreg; *(LAS u32x4*)(lds + OFF_V + vst) = vreg;
    __syncthreads();
    f32x16 o0 = {}, o1 = {};
    float mrun = -INFINITY, lsum = 0.f, carry = 0.f;
    bool alive = true;
    const int kfr = l32 * KPITCH + hi * 16;
    const int vfr = (4 * hi + ((lane & 15) >> 2)) * 64 + ((lane >> 4) & 1) * 32 + (lane & 3) * 8;
    const int tq = T0 + l32;
    for (int i = 0; i < n; ++i) {
        const int tile = TILE_OF(i); const int buf = i & 1;
        const bool more = (i + 1 < n);
        if (more) { const int t1 = TILE_OF(i + 1); kreg = *(const u32x4*)(Kg + (size_t)t1 * 64 * QKVW); vreg = *(const u32x4*)(Vg + (size_t)t1 * 64 * QKVW); }
        const bool act = MODE == 0 ? (tile >= cw - 8 && tile <= cw) : (tile <= cw && alive);
        if (act) {
            f32x16 p[2];
            LAS const unsigned char* kb_ = lds + OFF_K + buf * KTILE + kfr;
#pragma unroll
            for (int kb = 0; kb < 2; ++kb) { f32x16 a = {};
#pragma unroll
                for (int d0 = 0; d0 < 4; ++d0) { const bf16x8 kf = *(const LAS bf16x8*)(kb_ + kb * 32 * KPITCH + d0 * 32); a = __builtin_amdgcn_mfma_f32_32x32x16_bf16(kf, qf[d0], a, 0, 0, 0); }
                p[kb] = a; }
            const int tk0 = tile * 64 + 4 * hi;
            if (MODE == 0) {
                float rm = -INFINITY;
                const int rel0 = tq - tk0;
                const bool far = (T0 - tile * 64 - 63 >= 256);
                if (far) { const float bb = biasl[512];
#pragma unroll
                    for (int kb = 0; kb < 2; ++kb)
#pragma unroll
                        for (int r = 0; r < 16; ++r) { const float s = p[kb][r] * (0.125f * LOG2E) + bb; p[kb][r] = s; rm = fmaxf(rm, s); }
                } else {
#pragma unroll
                    for (int kb = 0; kb < 2; ++kb)
#pragma unroll
                        for (int r = 0; r < 16; ++r) { int rel = rel0 - 32 * kb - (r & 3) - 8 * (r >> 2); rel = rel > 256 ? 256 : rel;
                            const float s = p[kb][r] * (0.125f * LOG2E) + biasl[rel + 256]; p[kb][r] = s; rm = fmaxf(rm, s); }
                }
                rm = fmaxf(rm, __shfl_xor(rm, 32));
                const float mnew = fmaxf(mrun, rm); const float alpha = __builtin_amdgcn_exp2f(mrun - mnew); mrun = mnew;
                float ps = 0.f;
#pragma unroll
                for (int kb = 0; kb < 2; ++kb)
#pragma unroll
                    for (int r = 0; r < 16; ++r) { const float e = __builtin_amdgcn_exp2f(p[kb][r] - mnew); p[kb][r] = e; ps += e; }
                lsum = lsum * alpha + ps;
#pragma unroll
                for (int r = 0; r < 16; ++r) { o0[r] *= alpha; o1[r] *= alpha; }
            } else {
                const bool diag = (tile == cw);
                f32x16 l1v[2]; float G[8];
#pragma unroll
                for (int kb = 0; kb < 2; ++kb)
#pragma unroll
                    for (int g = 0; g < 4; ++g) { float gs = 0.f;
#pragma unroll
                        for (int e = 0; e < 4; ++e) { const int r = 4 * g + e; const float z = p[kb][r] * 0.125f;
                            const float sp = __builtin_amdgcn_logf(1.0f + __builtin_amdgcn_exp2f(-fabsf(z) * LOG2E)) * 0.6931471805599453f;
                            float lb = fminf(z, 0.f) - sp; float l1 = lb - z;
                            if (diag) { const int tk = tk0 + 32 * kb + 8 * g + e; if (tk >= tq) { l1 = 0.f; lb = -INFINITY; } }
                            p[kb][r] = lb; l1v[kb][r] = l1; gs += l1; }
                        G[4 * kb + g] = gs; }
                float Gp[8];
#pragma unroll
                for (int k = 0; k < 8; ++k) Gp[k] = __shfl_xor(G[k], 32);
                float R = 0.f; float suf[8];
#pragma unroll
                for (int k = 7; k >= 0; --k) { suf[k] = R + (hi == 0 ? Gp[k] : 0.f); R += G[k] + Gp[k]; }
#pragma unroll
                for (int kb = 0; kb < 2; ++kb)
#pragma unroll
                    for (int g = 0; g < 4; ++g) { float run = carry + suf[4 * kb + g];
#pragma unroll
                        for (int e = 3; e >= 0; --e) { const int r = 4 * g + e; const float wgt = __builtin_amdgcn_exp2f((p[kb][r] + run) * LOG2E); run += l1v[kb][r]; p[kb][r] = wgt; } }
                carry += R;
                alive = __builtin_amdgcn_ballot_w64(carry > SB_CUT) != 0ull;
            }
            bf16x8 pf[4];
#pragma unroll
            for (int ks = 0; ks < 4; ++ks) { const int kb = ks >> 1, r0 = 8 * (ks & 1);
                u32x4 t; t.x = cvtpk(p[kb][r0], p[kb][r0 + 1]); t.y = cvtpk(p[kb][r0 + 2], p[kb][r0 + 3]); t.z = cvtpk(p[kb][r0 + 4], p[kb][r0 + 5]); t.w = cvtpk(p[kb][r0 + 6], p[kb][r0 + 7]);
                pf[ks] = __builtin_bit_cast(bf16x8, t); }
            LAS const unsigned char* vb_ = lds + OFF_V + buf * VTILE + vfr;
#pragma unroll
            for (int ks = 0; ks < 4; ++ks) {
                { const v4i16_t lo = vtr(vb_ + ks * 1024), up = vtr(vb_ + ks * 1024 + 512);
                  const bf16x8 vf = {lo[0], lo[1], lo[2], lo[3], up[0], up[1], up[2], up[3]};
                  o0 = __builtin_amdgcn_mfma_f32_32x32x16_bf16(vf, pf[ks], o0, 0, 0, 0); }
                { const v4i16_t lo = vtr(vb_ + 4096 + ks * 1024), up = vtr(vb_ + 4096 + ks * 1024 + 512);
                  const bf16x8 vf = {lo[0], lo[1], lo[2], lo[3], up[0], up[1], up[2], up[3]};
                  o1 = __builtin_amdgcn_mfma_f32_32x32x16_bf16(vf, pf[ks], o1, 0, 0, 0); }
            }
        }
        if (more) { *(LAS u32x4*)(lds + OFF_K + (buf ^ 1) * KTILE + kst) = kreg; *(LAS u32x4*)(lds + OFF_V + (buf ^ 1) * VTILE + vst) = vreg; }
        if (MODE == 1) { if (lane == 0) flags[buf * 8 + w] = alive ? 1 : 0; }
        __syncthreads();
        if (MODE == 1) { int any = 0;
#pragma unroll
            for (int k = 0; k < 8; ++k) any |= flags[buf * 8 + k];
            if (!any) break; }
    }
    float inv = 1.0f;
    if (MODE == 0) { const float l = lsum + __shfl_xor(lsum, 32); inv = 1.0f / l; }
    bf16_t* op = O + (rowbase + T0 + l32) * DM + OOFF + h * 64 + 4 * hi;
#pragma unroll
    for (int g4 = 0; g4 < 4; ++g4) {
        u32x2 a, c; a.x = cvtpk(o0[4 * g4] * inv, o0[4 * g4 + 1] * inv); a.y = cvtpk(o0[4 * g4 + 2] * inv, o0[4 * g4 + 3] * inv);
        c.x = cvtpk(o1[4 * g4] * inv, o1[4 * g4 + 1] * inv); c.y = cvtpk(o1[4 * g4 + 2] * inv, o1[4 * g4 + 3] * inv);
        *(u32x2*)(op + 8 * g4) = a; *(u32x2*)(op + 32 + 8 * g4) = c; }
#undef TILE_OF
}
}

constexpr size_t MiB = 1u << 20;
constexpr size_t WS_NSP = 1 * MiB;
constexpr size_t WS_W_ATT_IN = 2 * MiB;
constexpr size_t WS_W_ATT_OUT = 14 * MiB;
constexpr size_t WS_W_RG_IN = 18 * MiB;
constexpr size_t WS_W_RG_OUT = 26 * MiB;
constexpr size_t WS_W_RG_GATES = 30 * MiB;
constexpr size_t WS_W_GU = 32 * MiB;
constexpr size_t WS_W_DOWN = 76 * MiB;
constexpr size_t WS_SUMP = 98 * MiB, WS_SUMH = 99 * MiB;
constexpr size_t WS_S0 = 100 * MiB, WS_S1 = 132 * MiB, WS_S2 = 164 * MiB, WS_S3 = 196 * MiB, WS_END = 228 * MiB;

struct Args {
    const float* x; const float* attn_w_in; const float* attn_rel_bias; const float* attn_w_out; const float* rg_w_in; const float* rg_conv_w; const float* rg_conv_b;
    const float* rg_w_a; const float* rg_b_a; const float* rg_w_i; const float* rg_b_i; const float* rg_lambda; const float* rg_w_out;
    const float* norm_mix_pre; const float* norm_mix_post; const float* norm_ffn_pre; const float* norm_ffn_post;
    const float* ffn_w_gate; const float* ffn_w_up; const float* ffn_w_down;
    float* out; unsigned char* ws;
};

#define XB_TMO      128
#define XB_XCNT(j)  (256  + 64 * (j))
#define XB_XSUB(j)  (1280 + 64 * (j))
#define XB_XGEN(j)  (2304 + 64 * (j))
#define XB_TOP      3328
#define XB_TOPGEN   3392
#define XCD_BAR_WORDS 3456
#define XB_SPIN_CAP (1u << 18)

__device__ __forceinline__ unsigned xb_ld(unsigned* p)              { return __hip_atomic_load(p, __ATOMIC_RELAXED, __HIP_MEMORY_SCOPE_AGENT); }
__device__ __forceinline__ unsigned xb_add(unsigned* p, unsigned v) { return __hip_atomic_fetch_add(p, v, __ATOMIC_RELAXED, __HIP_MEMORY_SCOPE_AGENT); }
__device__ __forceinline__ unsigned xb_xcc_id() { return (unsigned)__builtin_amdgcn_s_getreg((3 << 11) | 20) & 0xFu; }
#define XB_SPIN(cond, bar) do { unsigned _sp = 0; while (cond) { __builtin_amdgcn_s_sleep(1); \
    if ((++_sp & 255u) == 0u) { if (xb_ld(&(bar)[XB_TMO])) break; if (_sp > XB_SPIN_CAP) { atomicAdd(&(bar)[XB_TMO], 1u); break; } } } } while (0)

struct XcdBarrier {
    unsigned* bar; unsigned x;
    volatile LAS unsigned* st;
};

__device__ __forceinline__ XcdBarrier xcd_barrier_post(unsigned* bar, volatile LAS unsigned* st) {
    XcdBarrier b; b.bar = bar; b.x = xb_xcc_id(); b.st = st;
    if (threadIdx.x == 0) (void)xb_add(&bar[XB_XCNT(b.x)], 1u);
    return b;
}
__device__ __forceinline__ void xcd_barrier_complete(unsigned* bar, unsigned x, unsigned& nloc, unsigned& nx) {
    const unsigned G = gridDim.x * gridDim.y * gridDim.z;
    unsigned sum, cnt, mine, sp = 0u;
    for (;;) {
        sum = 0u; cnt = 0u; mine = 0u;
#pragma unroll
        for (unsigned j = 0; j < 16; ++j) { const unsigned c = xb_ld(&bar[XB_XCNT(j)]); sum += c; cnt += (c > 0u) ? 1u : 0u; mine = (j == x) ? c : mine; }
        if (sum == G) break;
        __builtin_amdgcn_s_sleep(1);
        if ((++sp & 255u) == 0u) { if (xb_ld(&bar[XB_TMO])) break; if (sp > XB_SPIN_CAP) { atomicAdd(&bar[XB_TMO], 1u); break; } }
    }
    nloc = mine > 0u ? mine : 1u; nx = cnt > 0u ? cnt : 1u;
}

__device__ __forceinline__ void xcd_barrier(const XcdBarrier& b) {
    asm volatile("s_waitcnt vmcnt(0)" ::: "memory");
    __syncthreads();
    if (threadIdx.x == 0) {
        unsigned* bar = b.bar;
        __builtin_amdgcn_s_waitcnt(0);
        unsigned nloc = b.st[0], nx = b.st[1];
        if (nloc == 0u) { xcd_barrier_complete(bar, b.x, nloc, nx); b.st[0] = nloc; b.st[1] = nx; }
        const unsigned old = xb_add(&bar[XB_XSUB(b.x)], 1u);
        const unsigned gen = old / nloc;
        if (old + 1u == (gen + 1u) * nloc) {
            __builtin_amdgcn_fence(__ATOMIC_RELEASE, "agent");
            asm volatile("s_waitcnt vmcnt(0)" ::: "memory");
            const unsigned og = xb_add(&bar[XB_TOP], 1u);
            const unsigned tg = og / nx;
            if (og + 1u == (tg + 1u) * nx) xb_add(&bar[XB_TOPGEN], 1u);
            else XB_SPIN(xb_ld(&bar[XB_TOPGEN]) == tg, bar);
            __builtin_amdgcn_fence(__ATOMIC_ACQUIRE, "agent");
            xb_add(&bar[XB_XGEN(b.x)], 1u);
            asm volatile("s_waitcnt vmcnt(0)" ::: "memory");
        } else {
            XB_SPIN(xb_ld(&bar[XB_XGEN(b.x)]) == gen, bar);
            __builtin_amdgcn_fence(__ATOMIC_ACQUIRE, "agent");
            asm volatile("s_waitcnt vmcnt(0)" ::: "memory");
        }
    }
    __syncthreads();
}


__device__ __forceinline__ unsigned long long karg_ld(int off) {
    auto kp = __builtin_amdgcn_kernarg_segment_ptr();
    unsigned long long r;
    asm volatile("s_load_dwordx2 %0, %1, %2\n\ts_waitcnt lgkmcnt(0)" : "=s"(r) : "s"(kp), "n"(off));
    return r;
}
#define KA(field) ((decltype(Args::field))karg_ld((int)__builtin_offsetof(Args, field)))
#define WSB(off) ((bf16_t*)(KA(ws) + (off)))
__device__ __forceinline__ float wave_sum(float v) {
#pragma unroll
    for (int o = 1; o < 64; o <<= 1) v += __shfl_xor(v, o);
    return v;
}
__device__ __forceinline__ void transpose_item(const float* __restrict__ W, int K, int N, bf16_t* __restrict__ WT, int base, bool inter, LAS float* scr, int item, int lane) {
    const int nblk = N / 32, kb = item / nblk, nb = item % nblk, k0 = 64 * kb, n0 = 32 * nb;
#pragma unroll 8
    for (int i = 0; i < 32; ++i) { const int kk = 2 * i + (lane >> 5); scr[kk * 33 + (lane & 31)] = W[(size_t)(k0 + kk) * N + n0 + (lane & 31)]; }
    asm volatile("s_waitcnt lgkmcnt(0)" ::: "memory");
    const int c = lane & 7;
    const int drow0 = base + (inter ? ((n0 >> 7) * 256 + (n0 & 127)) : n0);
#pragma unroll
    for (int j = 0; j < 4; ++j) { const int nn = (lane >> 3) + 8 * j; const LAS float* s = scr + (8 * c) * 33 + nn;
        u32x4 o; o.x = cvtpk(s[0 * 33], s[1 * 33]); o.y = cvtpk(s[2 * 33], s[3 * 33]); o.z = cvtpk(s[4 * 33], s[5 * 33]); o.w = cvtpk(s[6 * 33], s[7 * 33]);
        *(u32x4*)(WT + (size_t)(drow0 + nn) * K + k0 + 8 * c) = o; }
    asm volatile("s_waitcnt lgkmcnt(0)" ::: "memory");
}

__device__ __forceinline__ void rowpass(const float* xin, const bf16_t* mrow, const float* __restrict__ gpost, float* xout,
                                        const float* __restrict__ gpre, bf16_t* hout, int gw, int NGW, int lane) {
    f32x4 gp[4], gq[4];
#pragma unroll
    for (int j = 0; j < 4; ++j) { gp[j] = mrow ? ((const f32x4*)gpost)[lane + 64 * j] : (f32x4){0.f, 0.f, 0.f, 0.f}; gq[j] = gpre ? ((const f32x4*)gpre)[lane + 64 * j] : (f32x4){0.f, 0.f, 0.f, 0.f}; }
    for (int row = gw; row < M; row += NGW) {
        f32x4 v[4];
#pragma unroll
        for (int j = 0; j < 4; ++j) v[j] = ((const f32x4*)(xin + (size_t)row * DM))[lane + 64 * j];
        if (mrow) {
            f32x4 mv[4]; float s = 0.f;
#pragma unroll
            for (int j = 0; j < 4; ++j) { const u32x2 t = ((const u32x2*)(mrow + (size_t)row * DM))[lane + 64 * j]; mv[j] = (f32x4){bf_lo(t.x), bf_hi(t.x), bf_lo(t.y), bf_hi(t.y)};
                s += (mv[j].x * mv[j].x + mv[j].y * mv[j].y) + (mv[j].z * mv[j].z + mv[j].w * mv[j].w); }
            const float sc = 1.0f / sqrtf(wave_sum(s) * (1.0f / DM) + RMS_EPS);
#pragma unroll
            for (int j = 0; j < 4; ++j) v[j] = v[j] + mv[j] * sc * gp[j];
        }
        if (xout) {
#pragma unroll
            for (int j = 0; j < 4; ++j) ((f32x4*)(xout + (size_t)row * DM))[lane + 64 * j] = v[j];
        }
        if (gpre) {
            float s2 = 0.f;
#pragma unroll
            for (int j = 0; j < 4; ++j) s2 += (v[j].x * v[j].x + v[j].y * v[j].y) + (v[j].z * v[j].z + v[j].w * v[j].w);
            const float r = 1.0f / sqrtf(wave_sum(s2) * (1.0f / DM) + RMS_EPS);
#pragma unroll
            for (int j = 0; j < 4; ++j) { const f32x4 hv = v[j] * r * gq[j]; u32x2 t; t.x = cvtpk(hv.x, hv.y); t.y = cvtpk(hv.z, hv.w); ((u32x2*)(hout + (size_t)row * DM))[lane + 64 * j] = t; }
        }
    }
}

__device__ __forceinline__ void conv_phase(const bf16_t* __restrict__ xr, bf16_t* __restrict__ xc, const float* __restrict__ cw, const float* __restrict__ cbp, int gt, int nthr) {
    for (int it = gt; it < 1024 * 128; it += nthr) {
        const int cgp = it & 127, run = it >> 7, c0 = cgp * 8, r0 = run * 16;
        float cwt[4][8], cb[8];
#pragma unroll
        for (int t = 0; t < 4; ++t)
#pragma unroll
            for (int e = 0; e < 8; ++e) cwt[t][e] = cw[(size_t)t * DM + c0 + e];
#pragma unroll
        for (int e = 0; e < 8; ++e) cb[e] = cbp[c0 + e];
        float hst[3][8];
        const bool first = (r0 % SEQ) == 0;
#pragma unroll
        for (int t = 0; t < 3; ++t) { u32x4 q = {0u, 0u, 0u, 0u}; if (!first) q = *(const u32x4*)(xr + (size_t)(r0 - 3 + t) * DM + c0);
            hst[t][0] = bf_lo(q.x); hst[t][1] = bf_hi(q.x); hst[t][2] = bf_lo(q.y); hst[t][3] = bf_hi(q.y); hst[t][4] = bf_lo(q.z); hst[t][5] = bf_hi(q.z); hst[t][6] = bf_lo(q.w); hst[t][7] = bf_hi(q.w); }
#pragma unroll 4
        for (int r = 0; r < 16; ++r) {
            const u32x4 q = *(const u32x4*)(xr + (size_t)(r0 + r) * DM + c0);
            float cur[8] = {bf_lo(q.x), bf_hi(q.x), bf_lo(q.y), bf_hi(q.y), bf_lo(q.z), bf_hi(q.z), bf_lo(q.w), bf_hi(q.w)};
            float ov[8];
#pragma unroll
            for (int e = 0; e < 8; ++e) { ov[e] = cb[e] + cwt[0][e] * hst[0][e] + cwt[1][e] * hst[1][e] + cwt[2][e] * hst[2][e] + cwt[3][e] * cur[e];
                hst[0][e] = hst[1][e]; hst[1][e] = hst[2][e]; hst[2][e] = cur[e]; }
            u32x4 o; o.x = cvtpk(ov[0], ov[1]); o.y = cvtpk(ov[2], ov[3]); o.z = cvtpk(ov[4], ov[5]); o.w = cvtpk(ov[6], ov[7]);
            *(u32x4*)(xc + (size_t)(r0 + r) * DM + c0) = o;
        }
    }
}
__device__ __forceinline__ void scan1_phase(const bf16_t* __restrict__ LA, const bf16_t* __restrict__ U, float* __restrict__ sumP, float* __restrict__ sumH, int gt, int nthr) {
    for (int it = gt; it < 256 * 512; it += nthr) {
        const int cp = it & 511, ch = it >> 9; const size_t base = (size_t)ch * 64 * DM + cp * 2;
        float P0 = 1.f, P1 = 1.f, H0 = 0.f, H1 = 0.f;
#pragma unroll 8
        for (int r = 0; r < 64; ++r) { const unsigned la = *(const unsigned*)(LA + base + (size_t)r * DM), uu = *(const unsigned*)(U + base + (size_t)r * DM);
            const float a0 = fast_exp(bf_lo(la)), a1 = fast_exp(bf_hi(la));
            P0 *= a0; P1 *= a1; H0 = a0 * H0 + bf_lo(uu); H1 = a1 * H1 + bf_hi(uu); }
        *(f32x2*)(sumP + (size_t)ch * DM + cp * 2) = (f32x2){P0, P1}; *(f32x2*)(sumH + (size_t)ch * DM + cp * 2) = (f32x2){H0, H1};
    }
}
__device__ __forceinline__ void scan2_phase(const bf16_t* __restrict__ LA, const bf16_t* __restrict__ U, bf16_t* GT, const float* __restrict__ sumP, const float* __restrict__ sumH, int gt, int nthr) {
    for (int it = gt; it < 256 * 512; it += nthr) {
        const int cp = it & 511, ch = it >> 9, c = ch & 127, ch0 = ch - c; const size_t base = (size_t)ch * 64 * DM + cp * 2;
        float H0 = 0.f, H1 = 0.f;
#pragma unroll 8
        for (int k = 0; k < c; ++k) { const f32x2 p = *(const f32x2*)(sumP + (size_t)(ch0 + k) * DM + cp * 2), hh = *(const f32x2*)(sumH + (size_t)(ch0 + k) * DM + cp * 2);
            H0 = p.x * H0 + hh.x; H1 = p.y * H1 + hh.y; }
#pragma unroll 8
        for (int r = 0; r < 64; ++r) { const unsigned la = *(const unsigned*)(LA + base + (size_t)r * DM), uu = *(const unsigned*)(U + base + (size_t)r * DM), gg = *(const unsigned*)(GT + base + (size_t)r * DM);
            const float a0 = fast_exp(bf_lo(la)), a1 = fast_exp(bf_hi(la));
            H0 = a0 * H0 + bf_lo(uu); H1 = a1 * H1 + bf_hi(uu);
            *(unsigned*)(GT + base + (size_t)r * DM) = cvtpk(H0 * bf_lo(gg), H1 * bf_hi(gg)); }
    }
}

#ifndef PH
#define PH 0xffff
#endif
constexpr int NTHREADS = 512, NWAVES = 8;
constexpr int LDS_BYTES = 147456;

__global__ void __launch_bounds__(NTHREADS, 2) mega_fwd(Args a) {
    extern __shared__ __attribute__((aligned(16))) unsigned char lds_raw[];
    LAS unsigned char* lds = (LAS unsigned char*)lds_raw;
    cg::grid_group grid = cg::this_grid();
    const int tid = threadIdx.x, lane = tid & 63; const int wave = __builtin_amdgcn_readfirstlane(tid >> 6);
    const int G = gridDim.x, bx = blockIdx.x;
    const int vcu = (G % 8 == 0) ? (bx % 8) * (G / 8) + bx / 8 : bx;
    const int gw = vcu * NWAVES + wave, NGW = G * NWAVES;
    volatile LAS unsigned* bst = (volatile LAS unsigned*)(lds + 131072 + 64);
    if (tid < 2) bst[tid] = 0u;
    __syncthreads();
    const XcdBarrier xbar = xcd_barrier_post((unsigned*)KA(ws), bst);
#define S0 WSB(WS_S0)
#define S1 WSB(WS_S1)
#define S2 WSB(WS_S2)
#define S3 WSB(WS_S3)
#define WSP KA(ws)

    {
        LAS float* scr = (LAS float*)(lds + wave * 16384);
        unsigned char* const wsl = WSP;
        int off = 0;
        for (int job = 0; job < 36; ++job) {
            const float* W; int K, N, base = 0; bool inter = false; bf16_t* WT;
            if (job < 2) { W = KA(attn_w_in) + (size_t)job * DM * QKVW; K = DM; N = QKVW; WT = (bf16_t*)(wsl + WS_W_ATT_IN) + (size_t)job * QKVW * DM; }
            else if (job < 4) { const int j = job - 2; W = KA(attn_w_out) + (size_t)j * DM * DM; K = DM; N = DM; WT = (bf16_t*)(wsl + WS_W_ATT_OUT) + (size_t)j * DM * DM; }
            else if (job < 6) { const int j = job - 4; W = KA(rg_w_in) + (size_t)j * DM * 2048; K = DM; N = 2048; WT = (bf16_t*)(wsl + WS_W_RG_IN) + (size_t)j * 2048 * DM; }
            else if (job < 8) { const int j = job - 6; W = KA(rg_w_out) + (size_t)j * DM * DM; K = DM; N = DM; WT = (bf16_t*)(wsl + WS_W_RG_OUT) + (size_t)j * DM * DM; }
            else if (job < 24) { const int idx = job - 8, j = idx >> 3, which = (idx >> 2) & 1, blk = idx & 3;
                W = (which ? KA(rg_w_i) : KA(rg_w_a)) + (size_t)(j * 4 + blk) * 65536; K = 256; N = 256; WT = (bf16_t*)(wsl + WS_W_RG_GATES) + (size_t)j * 2048 * 256; base = blk * 512 + which * 128; inter = true; }
            else if (job < 28) { const int l = job - 24; W = KA(ffn_w_gate) + (size_t)l * DM * DFF; K = DM; N = DFF; WT = (bf16_t*)(wsl + WS_W_GU) + (size_t)l * 2 * DFF * DM; base = 0; inter = true; }
            else if (job < 32) { const int l = job - 28; W = KA(ffn_w_up) + (size_t)l * DM * DFF; K = DM; N = DFF; WT = (bf16_t*)(wsl + WS_W_GU) + (size_t)l * 2 * DFF * DM; base = 128; inter = true; }
            else { const int l = job - 32; W = KA(ffn_w_down) + (size_t)l * DFF * DM; K = DFF; N = DM; WT = (bf16_t*)(wsl + WS_W_DOWN) + (size_t)l * DM * DFF; }
            const int nitems = (K / 64) * (N / 32);
            int first = gw - off; first %= NGW; if (first < 0) first += NGW;
            for (int it = first; it < nitems; it += NGW) transpose_item(W, K, N, WT, base, inter, scr, it, lane);
            off = (off + nitems) % NGW;
        }
    }
    { float* cst = (float*)(WSP + WS_NSP); const int gt = vcu * NTHREADS + tid; if (gt < 2 * DM) { const int jj = gt >> 10, c = gt & 1023;
        cst[jj * 3072 + c] = KA(rg_b_a)[gt]; cst[jj * 3072 + 1024 + c] = KA(rg_b_i)[gt]; cst[jj * 3072 + 2048 + c] = -8.0f * log1pf(expf(-KA(rg_lambda)[gt])); } }
    grid.sync();

    for (int step = 0; step <= DEPTH * 10; ++step) {
        const int layer = step / 10, sub = step - layer * 10, j = layer >> 1; const bool is_attn = (layer & 1) == 0, fin = (step == DEPTH * 10);
        if (!fin && is_attn && (sub == 3 || sub == 4 || sub == 5)) continue;
        if (fin || sub == 0 || sub == 7) {
            const float* xin; const bf16_t* mrow; const float* gpost; float* xout; const float* gpre; bf16_t* hout = S0;
            if (fin) { xin = KA(out); mrow = S0; gpost = KA(norm_ffn_post) + (size_t)(DEPTH - 1) * DM; xout = KA(out); gpre = nullptr; hout = nullptr; }
            else if (sub == 0) {
                if (layer == 0) { xin = KA(x); mrow = nullptr; gpost = nullptr; xout = nullptr; }
                else { xin = KA(out); mrow = S0; gpost = KA(norm_ffn_post) + (size_t)(layer - 1) * DM; xout = KA(out); }
                gpre = KA(norm_mix_pre) + (size_t)layer * DM;
            } else { xin = (layer == 0) ? KA(x) : KA(out); mrow = is_attn ? S1 : S2; gpost = KA(norm_mix_post) + (size_t)layer * DM; xout = KA(out); gpre = KA(norm_ffn_pre) + (size_t)layer * DM; }
            rowpass(xin, mrow, gpost, xout, gpre, hout, gw, NGW, lane);
        } else if (sub == 1 || sub == 3 || sub == 6 || sub == 8 || sub == 9) {
            unsigned oA, oB, oP0, oP1 = 0; int N, K = DM, lda = DM, ldb = DM, ash = 0, ael = 0, mode = pg8::EPI_STORE, ldc = DM;
            if (sub == 1) { oA = WS_S0; if (is_attn) { oB = WS_W_ATT_IN + j * (QKVW * DM * 2); N = QKVW; oP0 = WS_S1; ldc = QKVW; }
                            else { oB = WS_W_RG_IN + j * (2048 * DM * 2); N = 2048; mode = pg8::EPI_RECIN; oP0 = WS_S1; oP1 = WS_S2; } }
            else if (sub == 3) { oA = WS_S3; oB = WS_W_RG_GATES + j * (2048 * 256 * 2); N = 2048; K = 256; ldb = 256; ash = 1; ael = 256; mode = pg8::EPI_GATES; oP0 = 0; oP1 = WS_NSP + j * (3072 * 4); }
            else if (sub == 6) { N = DM; if (is_attn) { oA = WS_S0; oB = WS_W_ATT_OUT + j * (DM * DM * 2); oP0 = WS_S1; } else { oA = WS_S1; oB = WS_W_RG_OUT + j * (DM * DM * 2); oP0 = WS_S2; } }
            else if (sub == 8) { oA = WS_S0; oB = WS_W_GU + layer * (2 * DFF * DM * 2); N = 2 * DFF; mode = pg8::EPI_SWIGLU; oP0 = WS_S1; ldc = DFF; }
            else { oA = WS_S1; oB = WS_W_DOWN + layer * (DM * DFF * 2); N = DM; K = DFF; lda = DFF; ldb = DFF; oP0 = WS_S0; }
            unsigned char* const wsl = WSP;
            pg8::Gemm g{(const bf16_t*)(wsl + oA), (const bf16_t*)(wsl + oB), K, lda, ldb, ash, ael}; pg8::StaticOrder S; S.init(M, N, G, bx);
            pg8::Epi E{mode, wsl + oP0, wsl + oP1, ldc};
            pg8::gemm_phase<true>(lds, g, S, E);
        } else if (sub == 2) {
            if (is_attn) {
                for (int uu = vcu; uu < 1024; uu += G) {
                    const int uidx = uu & 511;
                    const int qb = uidx & 31, hh = (uidx >> 5) & 7, bb = uidx >> 8;
                    if (uu < 512) att::unit<0>(S1, S0, bb, hh, qb, KA(attn_rel_bias) + (size_t)(j * 8 + hh) * 513, lds);
                    else att::unit<1>(S1, S0, bb, hh, qb, nullptr, lds);
                }
            } else conv_phase(S2, S3, KA(rg_conv_w) + (size_t)j * 4 * DM, KA(rg_conv_b) + (size_t)j * DM, vcu * NTHREADS + tid, G * NTHREADS);
        } else if (sub == 4) scan1_phase(S2, S0, (float*)(WSP + WS_SUMP), (float*)(WSP + WS_SUMH), vcu * NTHREADS + tid, G * NTHREADS);
        else scan2_phase(S2, S0, S1, (const float*)(WSP + WS_SUMP), (const float*)(WSP + WS_SUMH), vcu * NTHREADS + tid, G * NTHREADS);
        if (!fin) xcd_barrier(xbar);
    }
}

#undef WSP
#undef S0
#undef S1
#undef S2
#undef S3
extern "C" void kernel_launch(void* const* d_in, const int* in_sizes, int n_in, void* d_out, int out_size, void* d_ws, size_t ws_size, hipStream_t stream) {
    static int grid = 0;
    if (grid == 0) {
        if (n_in != 20 || in_sizes[0] != M * DM || out_size != M * DM || ws_size < WS_END) { fprintf(stderr, "kernel_launch: unexpected shapes (n_in %d, in0 %d, out %d, ws %zu); nothing launched\n", n_in, n_in > 0 ? in_sizes[0] : -1, out_size, ws_size); grid = -1; return; }
        int dev = 0, cus = 0, per_cu = 0;
        if (hipGetDevice(&dev) != hipSuccess || hipDeviceGetAttribute(&cus, hipDeviceAttributeMultiprocessorCount, dev) != hipSuccess) { grid = -1; return; }
        if (hipFuncSetAttribute((const void*)mega_fwd, hipFuncAttributeMaxDynamicSharedMemorySize, LDS_BYTES) != hipSuccess) { fprintf(stderr, "kernel_launch: hipFuncSetAttribute failed\n"); grid = -1; return; }
        if (hipOccupancyMaxActiveBlocksPerMultiprocessor(&per_cu, (const void*)mega_fwd, NTHREADS, LDS_BYTES) != hipSuccess || per_cu < 1) { fprintf(stderr, "kernel_launch: occupancy query says %d\n", per_cu); per_cu = 1; }
        (void)hipGetLastError();
        grid = cus * 1;
    }
    if (grid < 0) return;
    if (hipMemsetAsync(d_ws, 0, 16384, stream) != hipSuccess) { fprintf(stderr, "kernel_launch: memset of the barrier words failed\n"); return; }
    Args a{};
    a.x = (const float*)d_in[0]; a.attn_w_in = (const float*)d_in[1]; a.attn_rel_bias = (const float*)d_in[2]; a.attn_w_out = (const float*)d_in[3];
    a.rg_w_in = (const float*)d_in[4]; a.rg_conv_w = (const float*)d_in[5]; a.rg_conv_b = (const float*)d_in[6]; a.rg_w_a = (const float*)d_in[7]; a.rg_b_a = (const float*)d_in[8];
    a.rg_w_i = (const float*)d_in[9]; a.rg_b_i = (const float*)d_in[10]; a.rg_lambda = (const float*)d_in[11]; a.rg_w_out = (const float*)d_in[12];
    a.norm_mix_pre = (const float*)d_in[13]; a.norm_mix_post = (const float*)d_in[14]; a.norm_ffn_pre = (const float*)d_in[15]; a.norm_ffn_post = (const float*)d_in[16];
    a.ffn_w_gate = (const float*)d_in[17]; a.ffn_w_up = (const float*)d_in[18]; a.ffn_w_down = (const float*)d_in[19];
    a.out = (float*)d_out; a.ws = (unsigned char*)d_ws;
    void* args[] = {&a};
    hipError_t e = hipLaunchCooperativeKernel((const void*)mega_fwd, dim3(grid), dim3(NTHREADS), args, LDS_BYTES, stream);
    if (e != hipSuccess) fprintf(stderr, "kernel_launch: cooperative launch failed: %s (grid %d)\n", hipGetErrorString(e), grid);
}
```

```cpp
#include <hip/hip_runtime.h>
#include <hip/hip_cooperative_groups.h>
#include <cstdio>
#include <cstdint>
namespace cg = cooperative_groups;

#define LAS __attribute__((address_space(3)))
typedef unsigned short bf16_t;
typedef short bf16x8 __attribute__((ext_vector_type(8)));
typedef float f32x4 __attribute__((ext_vector_type(4)));
typedef float f32x2 __attribute__((ext_vector_type(2)));
typedef float f32x16 __attribute__((ext_vector_type(16)));
typedef unsigned u32x4 __attribute__((ext_vector_type(4)));
typedef unsigned u32x2 __attribute__((ext_vector_type(2)));
typedef __bf16 bf16x2_t __attribute__((ext_vector_type(2)));

constexpr int BATCH = 2, SEQ = 8192, DM = 1024, DEPTH = 4, M = BATCH * SEQ;
constexpr int DFF = 2816, QKVW = 3072;
constexpr float RMS_EPS = 1e-6f;
constexpr float LOG2E = 1.4426950408889634f;

__device__ __forceinline__ unsigned cvtpk(float lo, float hi) { f32x2 v = {lo, hi}; bf16x2_t b = __builtin_convertvector(v, bf16x2_t); return __builtin_bit_cast(unsigned, b); }
__device__ __forceinline__ float bf_lo(unsigned w) { return __uint_as_float(w << 16); }
__device__ __forceinline__ float bf_hi(unsigned w) { return __uint_as_float(w & 0xffff0000u); }
__device__ __forceinline__ float fast_exp(float x) { return __builtin_amdgcn_exp2f(x * LOG2E); }
__device__ __forceinline__ float fast_sigmoid(float x) { return __builtin_amdgcn_rcpf(1.0f + fast_exp(-x)); }
__device__ __forceinline__ float silu_f(float x) { return x * fast_sigmoid(x); }
__device__ __forceinline__ float gelu_tanh_f(float x) { const float t = 1.5957691216057308f * (x + 0.044715f * x * x * x); return x * fast_sigmoid(t); }

namespace pg8 {
constexpr int BM = 256, BK = 64, HALF = 128, HTB = HALF * BK * 2, STAGE_BYTES = 8 * HTB, NXCD = 8, WGM = 8;

__host__ __device__ __forceinline__ int lds_byte(int r, int c) { const int st = (r >> 4) * 2 + (c >> 5), rr = r & 15, cc = c & 31, ob = rr * 64 + cc * 2; return st * 1024 + (ob ^ (((ob >> 9) & 1) << 5)); }
__host__ __device__ __forceinline__ void stage_rc(int b, int& R, int& C) { const int st = b / 1024, sb = b % 1024, swz = sb ^ (((sb >> 9) & 1) << 5); R = (st >> 1) * 16 + swz / 64; C = (st & 1) * 32 + (swz % 64) / 2; }
__host__ __device__ __forceinline__ int perm32(int rho) { const int n = rho >> 4, i = rho & 15; return 8 * (i >> 2) + 4 * n + (i & 3); }

struct Unit { int pm, pn; };
struct Gemm { const bf16_t* A; const bf16_t* Bt; int K, lda, ldb, apn_shift, apn_elems; };

struct StaticOrder {
    int nM, nN, nwg, G, c;
    __host__ __device__ void init(int M_, int N_, int G_, int c_) { nM = M_ / BM; nN = N_ / BM; nwg = nM * nN; G = G_; c = c_; }
    __host__ __device__ bool next(int i, Unit& u) const {
        const long L = (long)i * G + c; if (L >= nwg) return false;
        int wgid = (int)L; { const int q = nwg / NXCD, r = nwg % NXCD, xcd = wgid % NXCD, off = wgid / NXCD; wgid = (xcd < r ? xcd * (q + 1) : r * (q + 1) + (xcd - r) * q) + off; }
        const int nig = WGM * nN, gid = wgid / nig, fm = gid * WGM, gsz = (nM - fm) < WGM ? (nM - fm) : WGM;
        u.pm = fm + ((wgid % nig) % gsz); u.pn = (wgid % nig) / gsz; return true;
    }
};

enum { EPI_STORE = 0, EPI_SWIGLU = 1, EPI_RECIN = 2, EPI_GATES = 3 };

struct Epi {
    int mode; unsigned char* p0; unsigned char* p1; int ldc;
    __device__ __forceinline__ void operator()(const f32x4 (&acc)[2][2][4][2], const Unit& u, int wr, int wc, int fr, int fq) const {
        const int row0 = u.pm * BM + wr * 64 + fr;
        if (mode == EPI_STORE) {
            bf16_t* O = (bf16_t*)p0; const int col0 = u.pn * BM + wc * 32 + 8 * fq;
#pragma unroll
            for (int ai = 0; ai < 2; ++ai)
#pragma unroll
                for (int m = 0; m < 4; ++m) { bf16_t* rowp = O + (size_t)(row0 + ai * HALF + m * 16) * ldc + col0;
#pragma unroll
                    for (int bj = 0; bj < 2; ++bj) { const f32x4 v0 = acc[ai][bj][m][0], v1 = acc[ai][bj][m][1];
                        u32x4 w; w.x = cvtpk(v0[0], v0[1]); w.y = cvtpk(v0[2], v0[3]); w.z = cvtpk(v1[0], v1[1]); w.w = cvtpk(v1[2], v1[3]);
                        *(u32x4*)(rowp + bj * HALF) = w; } }
        } else if (mode == EPI_SWIGLU) {
            bf16_t* O = (bf16_t*)p0; const int col0 = u.pn * HALF + wc * 32 + 8 * fq;
#pragma unroll
            for (int ai = 0; ai < 2; ++ai)
#pragma unroll
                for (int m = 0; m < 4; ++m) { bf16_t* rowp = O + (size_t)(row0 + ai * HALF + m * 16) * ldc + col0;
                    const f32x4 g0 = acc[ai][0][m][0], g1 = acc[ai][0][m][1], u0 = acc[ai][1][m][0], u1 = acc[ai][1][m][1];
                    u32x4 w; w.x = cvtpk(silu_f(g0[0]) * u0[0], silu_f(g0[1]) * u0[1]); w.y = cvtpk(silu_f(g0[2]) * u0[2], silu_f(g0[3]) * u0[3]);
                    w.z = cvtpk(silu_f(g1[0]) * u1[0], silu_f(g1[1]) * u1[1]); w.w = cvtpk(silu_f(g1[2]) * u1[2], silu_f(g1[3]) * u1[3]);
                    *(u32x4*)rowp = w; }
        } else if (mode == EPI_RECIN) {
            const bool isg = u.pn < 4; bf16_t* base = (bf16_t*)(isg ? p0 : p1);
            const int col0 = (u.pn & 3) * BM + wc * 32 + 8 * fq;
#pragma unroll
            for (int ai = 0; ai < 2; ++ai)
#pragma unroll
                for (int m = 0; m < 4; ++m) { bf16_t* rowp = base + (size_t)(row0 + ai * HALF + m * 16) * DM + col0;
#pragma unroll
                    for (int bj = 0; bj < 2; ++bj) { f32x4 v0 = acc[ai][bj][m][0], v1 = acc[ai][bj][m][1];
                        if (isg) {
#pragma unroll
                            for (int e = 0; e < 4; ++e) { v0[e] = gelu_tanh_f(v0[e]); v1[e] = gelu_tanh_f(v1[e]); } }
                        u32x4 w; w.x = cvtpk(v0[0], v0[1]); w.y = cvtpk(v0[2], v0[3]); w.z = cvtpk(v1[0], v1[1]); w.w = cvtpk(v1[2], v1[3]);
                        *(u32x4*)(rowp + bj * HALF) = w; } }
        } else {
            const int ch0 = u.pn * HALF + wc * 32 + 8 * fq; const float* cst = (const float*)p1;
            const bf16_t* XC = (const bf16_t*)(p0 + (196u << 20)); bf16_t* LA = (bf16_t*)(p0 + (164u << 20)); bf16_t* U = (bf16_t*)(p0 + (100u << 20));
#pragma unroll
            for (int n = 0; n < 2; ++n) {
                const f32x4 vba = *(const f32x4*)(cst + ch0 + 4 * n), vbi = *(const f32x4*)(cst + 1024 + ch0 + 4 * n), nsp = *(const f32x4*)(cst + 2048 + ch0 + 4 * n);
#pragma unroll
                for (int ai = 0; ai < 2; ++ai)
#pragma unroll
                    for (int m = 0; m < 4; ++m) { const size_t off = (size_t)(row0 + ai * HALF + m * 16) * DM + ch0 + 4 * n;
                        const u32x2 xw = *(const u32x2*)(XC + off);
                        const float xc[4] = {bf_lo(xw.x), bf_hi(xw.x), bf_lo(xw.y), bf_hi(xw.y)};
                        float la[4], uu[4];
#pragma unroll
                        for (int e = 0; e < 4; ++e) { const float pa = acc[ai][0][m][n][e] + vba[e], pi = acc[ai][1][m][n][e] + vbi[e];
                            const float r = fast_sigmoid(pa), ig = fast_sigmoid(pi);
                            la[e] = nsp[e] * r;
                            const float x2 = 2.0f * la[e];
                            const float ser = -x2 * (1.0f + x2 * (0.5f + x2 * (0.16666667f + x2 * (0.041666668f + x2 * (0.008333334f + x2 * (0.0013888889f + x2 * 0.0001984127f))))));
                            const float om = x2 > -0.3f ? ser : 1.0f - fast_exp(x2);
                            uu[e] = __builtin_amdgcn_sqrtf(om) * ig * xc[e]; }
                        u32x2 w1, w2; w1.x = cvtpk(la[0], la[1]); w1.y = cvtpk(la[2], la[3]); w2.x = cvtpk(uu[0], uu[1]); w2.y = cvtpk(uu[2], uu[3]);
                        *(u32x2*)(LA + off) = w1; *(u32x2*)(U + off) = w2;
                        asm volatile("" ::: "memory"); }
            }
        }
    }
};

template <bool ALIGN_EPI>
__device__ __forceinline__ void gemm_phase(LAS unsigned char* lds, const Gemm g, const StaticOrder& S, const Epi& E) {
    const int tid = threadIdx.x, wid = __builtin_amdgcn_readfirstlane(tid >> 6), lane = tid & 63, wr = wid >> 2, wc = wid & 3, fr = lane & 15, fq = lane >> 4;
    const int K = g.K, nt = K / BK;
    unsigned voffA[2], voffB[2];
#pragma unroll
    for (int i = 0; i < 2; ++i) { int R, C; stage_rc(tid * 16 + i * 8192, R, C); const int Rb = (R & ~31) + perm32(R & 31);
        voffA[i] = (unsigned)(R * g.lda + C) * 2u; voffB[i] = (unsigned)(Rb * g.ldb + C) * 2u; }
    constexpr unsigned kstep = BK * 2;
    const unsigned hstepA = (unsigned)(HALF * g.lda * 2), hstepB = (unsigned)(HALF * g.ldb * 2);
    const unsigned tstepA = 2 * hstepA, tstepB = 2 * hstepB;
    const unsigned ldsw = (unsigned)wid * 1024u;
    const int aoff = lds_byte(wr * 64 + fr, fq * 8), boff = lds_byte(wc * 32 + fr, fq * 8);
#define PG8_SA(b, h) (((b) * 2 + (h)) * HTB)
#define PG8_SB(b, h) ((4 + (b) * 2 + (h)) * HTB)
#define PG8_STAGE(bufoff, gbase, soff, voff) do { _Pragma("unroll") for (int _i = 0; _i < 2; ++_i) \
        __builtin_amdgcn_global_load_lds((const unsigned*)((gbase) + (size_t)(unsigned)((soff) + (voff)[_i])), (LAS unsigned*)(lds + (bufoff) + ldsw + _i * 8192), 16, 0, 0); } while (0)
#define PG8_LDA(dst, b, h) do { _Pragma("unroll") for (int m = 0; m < 4; ++m) _Pragma("unroll") for (int k = 0; k < 2; ++k) dst[m][k] = *(const LAS bf16x8*)(lds + PG8_SA(b, h) + aoff + m * 2048 + k * 1024); } while (0)
#define PG8_LDB(dst, b, h) do { _Pragma("unroll") for (int n = 0; n < 2; ++n) _Pragma("unroll") for (int k = 0; k < 2; ++k) dst[n][k] = *(const LAS bf16x8*)(lds + PG8_SB(b, h) + boff + n * 2048 + k * 1024); } while (0)
#define PG8_MMA(ai, bj, At, Bt) do { __builtin_amdgcn_s_setprio(1); _Pragma("unroll") for (int m = 0; m < 4; ++m) _Pragma("unroll") for (int n = 0; n < 2; ++n) _Pragma("unroll") for (int k = 0; k < 2; ++k) \
        acc[ai][bj][m][n] = __builtin_amdgcn_mfma_f32_16x16x32_bf16(Bt[n][k], At[m][k], acc[ai][bj][m][n], 0, 0, 0); __builtin_amdgcn_s_setprio(0); } while (0)
#define PG8_WAIT_V(n) asm volatile("s_waitcnt vmcnt(" #n ")" ::: "memory")
#define PG8_WAIT_L(n) asm volatile("s_waitcnt lgkmcnt(" #n ")" ::: "memory")
#define PG8_BAR __builtin_amdgcn_s_barrier()
#define PG8_SCHED __builtin_amdgcn_sched_barrier(0)
#define PG8_UA(u) ((unsigned)(u).pm * tstepA + (unsigned)(((u).pn >> g.apn_shift) * g.apn_elems) * 2u)
#define PG8_UB(u) ((unsigned)(u).pn * tstepB)
    const char* const Ab = (const char*)g.A; const char* const Bb = (const char*)g.Bt;
    Unit cur, nxt; int ui = 0;
    if (!S.next(0, cur)) return;
    f32x4 acc[2][2][4][2];
#pragma unroll
    for (int a = 0; a < 2; ++a)
#pragma unroll
        for (int b = 0; b < 2; ++b)
#pragma unroll
            for (int m = 0; m < 4; ++m)
#pragma unroll
                for (int n = 0; n < 2; ++n) acc[a][b][m][n] = (f32x4){0.f, 0.f, 0.f, 0.f};
    bf16x8 At[4][2], B0[2][2], B1[2][2];
    unsigned cA = PG8_UA(cur), cB = PG8_UB(cur);
    PG8_STAGE(PG8_SB(0, 0), Bb, cB, voffB); PG8_STAGE(PG8_SB(0, 1), Bb, cB + hstepB, voffB); PG8_STAGE(PG8_SA(0, 0), Ab, cA, voffA); PG8_STAGE(PG8_SA(0, 1), Ab, cA + hstepA, voffA);
    if (wr == 1) PG8_BAR;
    PG8_WAIT_V(2); PG8_BAR;
    PG8_STAGE(PG8_SB(1, 0), Bb, cB + kstep, voffB); PG8_STAGE(PG8_SA(1, 0), Ab, cA + kstep, voffA); PG8_STAGE(PG8_SB(1, 1), Bb, cB + hstepB + kstep, voffB);
    PG8_WAIT_V(6); PG8_BAR;
    for (;;) {
        const bool has_next = S.next(ui + 1, nxt);
        const unsigned nA = has_next ? PG8_UA(nxt) : cA; const unsigned nB = has_next ? PG8_UB(nxt) : cB;
#pragma nounroll
        for (int t = 0; t < nt; t += 2) {
            const bool last = (t == nt - 2);
            const unsigned a1 = cA + (unsigned)(t + 1) * kstep;
            const unsigned a2 = last ? nA : cA + (unsigned)(t + 2) * kstep; const unsigned b2 = last ? nB : cB + (unsigned)(t + 2) * kstep;
            const unsigned a3 = a2 + kstep; const unsigned b3 = b2 + kstep;
            PG8_LDB(B0, 0, 0); PG8_LDB(B1, 0, 1); PG8_SCHED; PG8_LDA(At, 0, 0); PG8_STAGE(PG8_SA(1, 1), Ab, a1 + hstepA, voffA);
            PG8_WAIT_V(8); PG8_WAIT_L(0); PG8_BAR; PG8_MMA(0, 0, At, B0); PG8_MMA(0, 1, At, B1); PG8_BAR; PG8_SCHED;
            PG8_LDA(At, 0, 1); PG8_STAGE(PG8_SB(0, 0), Bb, b2, voffB); PG8_STAGE(PG8_SB(0, 1), Bb, b2 + hstepB, voffB); PG8_STAGE(PG8_SA(0, 0), Ab, a2, voffA);
            PG8_WAIT_V(8); PG8_WAIT_L(0); PG8_BAR; PG8_MMA(1, 0, At, B0); PG8_MMA(1, 1, At, B1); PG8_BAR; PG8_SCHED;
            PG8_LDB(B0, 1, 0); PG8_LDB(B1, 1, 1); PG8_SCHED; PG8_LDA(At, 1, 0); PG8_STAGE(PG8_SA(0, 1), Ab, a2 + hstepA, voffA);
            PG8_WAIT_V(8); PG8_WAIT_L(0); PG8_BAR; PG8_MMA(0, 0, At, B0); PG8_MMA(0, 1, At, B1); PG8_BAR; PG8_SCHED;
            PG8_LDA(At, 1, 1); PG8_STAGE(PG8_SB(1, 0), Bb, b3, voffB); PG8_STAGE(PG8_SB(1, 1), Bb, b3 + hstepB, voffB); PG8_STAGE(PG8_SA(1, 0), Ab, a3, voffA);
            PG8_WAIT_V(8); PG8_WAIT_L(0); PG8_BAR; PG8_MMA(1, 0, At, B0); PG8_MMA(1, 1, At, B1); PG8_BAR; PG8_SCHED;
        }
        if constexpr (ALIGN_EPI) { if (wr == 0) PG8_BAR; }
        E(acc, cur, wr, wc, fr, fq);
        if (!has_next) break;
#pragma unroll
        for (int a = 0; a < 2; ++a)
#pragma unroll
            for (int b = 0; b < 2; ++b)
#pragma unroll
                for (int m = 0; m < 4; ++m)
#pragma unroll
                    for (int n = 0; n < 2; ++n) acc[a][b][m][n] = (f32x4){0.f, 0.f, 0.f, 0.f};
        cur = nxt; cA = nA; cB = nB; ++ui;
        if constexpr (ALIGN_EPI) { if (wr == 1) PG8_BAR; }
    }
    PG8_WAIT_V(0);
    if constexpr (!ALIGN_EPI) { if (wr == 0) PG8_BAR; }
    PG8_BAR;
#undef PG8_SA
#undef PG8_SB
#undef PG8_STAGE
#undef PG8_LDA
#undef PG8_LDB
#undef PG8_MMA
#undef PG8_WAIT_V
#undef PG8_WAIT_L
#undef PG8_BAR
#undef PG8_SCHED
#undef PG8_UA
#undef PG8_UB
}
}

namespace att {
typedef short v4i16_t __attribute__((ext_vector_type(4)));
constexpr int KPITCH = 144;
constexpr int KTILE = 64 * KPITCH;
constexpr int VTILE = 8192;
constexpr int OFF_K = 0, OFF_V = 2 * KTILE, OFF_BIAS = OFF_V + 2 * VTILE, OFF_FLAG = OFF_BIAS + 2064, LDS_BYTES = OFF_FLAG + 64;
constexpr float SB_CUT = -104.0f;
__device__ __forceinline__ int crow(int r, int hi) { return (r & 3) + 8 * (r >> 2) + 4 * hi; }
__device__ __forceinline__ v4i16_t vtr(LAS const unsigned char* p) { return __builtin_amdgcn_ds_read_tr16_b64_v4i16((LAS v4i16_t*)p); }

template <int MODE>
__device__ __forceinline__ void unit(const bf16_t* __restrict__ qkv, bf16_t* __restrict__ O, int b, int h, int qb, const float* __restrict__ relb, LAS unsigned char* lds) {
    const int tid = threadIdx.x, lane = tid & 63, l32 = lane & 31, hi = lane >> 5; const int w = __builtin_amdgcn_readfirstlane(tid >> 6);
    constexpr int QOFF = MODE == 0 ? 0 : 1536, KOFF = QOFF + 512, VOFF = QOFF + 1024, OOFF = MODE == 0 ? 0 : 512;
    const size_t rowbase = (size_t)b * SEQ;
    const int T0 = qb * 256 + w * 32;
    const int cw = 4 * qb + (w >> 1);
    bf16x8 qf[4];
    { const bf16_t* qp = qkv + (rowbase + T0 + l32) * QKVW + QOFF + h * 64 + hi * 8;
#pragma unroll
      for (int d0 = 0; d0 < 4; ++d0) qf[d0] = *(const bf16x8*)(qp + d0 * 16); }
    const int t_hi = 4 * qb + 3, t_lo = MODE == 0 ? (4 * qb - 8 > 0 ? 4 * qb - 8 : 0) : 0;
    const int n = t_hi - t_lo + 1;
    const bf16_t* Kg = qkv + rowbase * QKVW + KOFF + h * 64 + (size_t)(tid >> 3) * QKVW + (tid & 7) * 8;
    const bf16_t* Vg = qkv + rowbase * QKVW + VOFF + h * 64 + (size_t)(tid >> 3) * QKVW + (tid & 7) * 8;
    const int kst = (tid >> 3) * KPITCH + (tid & 7) * 16;
    const int vst = ((tid & 7) >> 2) * 4096 + (tid >> 3) * 64 + (tid & 3) * 16;
    LAS float* biasl = (LAS float*)(lds + OFF_BIAS);
    LAS int* flags = (LAS int*)(lds + OFF_FLAG);
    if (MODE == 0) { for (int i = tid; i < 513; i += 512) biasl[i] = relb[i] * LOG2E; }
#define TILE_OF(i) (MODE == 0 ? t_lo + (i) : t_hi - (i))
    u32x4 kreg, vreg;
    { const int t0 = TILE_OF(0); kreg = *(const u32x4*)(Kg + (size_t)t0 * 64 * QKVW); vreg = *(const u32x4*)(Vg + (size_t)t0 * 64 * QKVW); }
    *(LAS u32x4*)(lds + OFF_K + kst) = kreg; *(LAS u32x4*)(lds + OFF_V + vst) = vreg;
    __syncthreads();
    f32x16 o0 = {}, o1 = {};
    float mrun = -INFINITY, lsum = 0.f, carry = 0.f;
    bool alive = true;
    const int kfr = l32 * KPITCH + hi * 16;
    const int vfr = (4 * hi + ((lane & 15) >> 2)) * 64 + ((lane >> 4) & 1) * 32 + (lane & 3) * 8;
    const int tq = T0 + l32;
    for (int i = 0; i < n; ++i) {
        const int tile = TILE_OF(i); const int buf = i & 1;
        const bool more = (i + 1 < n);
        if (more) { const int t1 = TILE_OF(i + 1); kreg = *(const u32x4*)(Kg + (size_t)t1 * 64 * QKVW); vreg = *(const u32x4*)(Vg + (size_t)t1 * 64 * QKVW); }
        const bool act = MODE == 0 ? (tile >= cw - 8 && tile <= cw) : (tile <= cw && alive);
        if (act) {
            f32x16 p[2];
            LAS const unsigned char* kb_ = lds + OFF_K + buf * KTILE + kfr;
#pragma unroll
            for (int kb = 0; kb < 2; ++kb) { f32x16 a = {};
#pragma unroll
                for (int d0 = 0; d0 < 4; ++d0) { const bf16x8 kf = *(const LAS bf16x8*)(kb_ + kb * 32 * KPITCH + d0 * 32); a = __builtin_amdgcn_mfma_f32_32x32x16_bf16(kf, qf[d0], a, 0, 0, 0); }
                p[kb] = a; }
            const int tk0 = tile * 64 + 4 * hi;
            if (MODE == 0) {
                float rm = -INFINITY;
                const int rel0 = tq - tk0;
                const bool far = (T0 - tile * 64 - 63 >= 256);
                if (far) { const float bb = biasl[512];
#pragma unroll
                    for (int kb = 0; kb < 2; ++kb)
#pragma unroll
                        for (int r = 0; r < 16; ++r) { const float s = p[kb][r] * (0.125f * LOG2E) + bb; p[kb][r] = s; rm = fmaxf(rm, s); }
                } else {
#pragma unroll
                    for (int kb = 0; kb < 2; ++kb)
#pragma unroll
                        for (int r = 0; r < 16; ++r) { int rel = rel0 - 32 * kb - (r & 3) - 8 * (r >> 2); rel = rel > 256 ? 256 : rel;
                            const float s = p[kb][r] * (0.125f * LOG2E) + biasl[rel + 256]; p[kb][r] = s; rm = fmaxf(rm, s); }
                }
                rm = fmaxf(rm, __shfl_xor(rm, 32));
                const float mnew = fmaxf(mrun, rm); const float alpha = __builtin_amdgcn_exp2f(mrun - mnew); mrun = mnew;
                float ps = 0.f;
#pragma unroll
                for (int kb = 0; kb < 2; ++kb)
#pragma unroll
                    for (int r = 0; r < 16; ++r) { const float e = __builtin_amdgcn_exp2f(p[kb][r] - mnew); p[kb][r] = e; ps += e; }
                lsum = lsum * alpha + ps;
#pragma unroll
                for (int r = 0; r < 16; ++r) { o0[r] *= alpha; o1[r] *= alpha; }
            } else {
                const bool diag = (tile == cw);
                f32x16 l1v[2]; float G[8];
#pragma unroll
                for (int kb = 0; kb < 2; ++kb)
#pragma unroll
                    for (int g = 0; g < 4; ++g) { float gs = 0.f;
#pragma unroll
                        for (int e = 0; e < 4; ++e) { const int r = 4 * g + e; const float z = p[kb][r] * 0.125f;
                            const float sp = __builtin_amdgcn_logf(1.0f + __builtin_amdgcn_exp2f(-fabsf(z) * LOG2E)) * 0.6931471805599453f;
                            float lb = fminf(z, 0.f) - sp; float l1 = lb - z;
                            if (diag) { const int tk = tk0 + 32 * kb + 8 * g + e; if (tk >= tq) { l1 = 0.f; lb = -INFINITY; } }
                            p[kb][r] = lb; l1v[kb][r] = l1; gs += l1; }
                        G[4 * kb + g] = gs; }
                float Gp[8];
#pragma unroll
                for (int k = 0; k < 8; ++k) Gp[k] = __shfl_xor(G[k], 32);
                float R = 0.f; float suf[8];
#pragma unroll
                for (int k = 7; k >= 0; --k) { suf[k] = R + (hi == 0 ? Gp[k] : 0.f); R += G[k] + Gp[k]; }
#pragma unroll
                for (int kb = 0; kb < 2; ++kb)
#pragma unroll
                    for (int g = 0; g < 4; ++g) { float run = carry + suf[4 * kb + g];
#pragma unroll
                        for (int e = 3; e >= 0; --e) { const int r = 4 * g + e; const float wgt = __builtin_amdgcn_exp2f((p[kb][r] + run) * LOG2E); run += l1v[kb][r]; p[kb][r] = wgt; } }
                carry += R;
                alive = __builtin_amdgcn_ballot_w64(carry > SB_CUT) != 0ull;
            }
            bf16x8 pf[4];
#pragma unroll
            for (int ks = 0; ks < 4; ++ks) { const int kb = ks >> 1, r0 = 8 * (ks & 1);
                u32x4 t; t.x = cvtpk(p[kb][r0], p[kb][r0 + 1]); t.y = cvtpk(p[kb][r0 + 2], p[kb][r0 + 3]); t.z = cvtpk(p[kb][r0 + 4], p[kb][r0 + 5]); t.w = cvtpk(p[kb][r0 + 6], p[kb][r0 + 7]);
                pf[ks] = __builtin_bit_cast(bf16x8, t); }
            LAS const unsigned char* vb_ = lds + OFF_V + buf * VTILE + vfr;
#pragma unroll
            for (int ks = 0; ks < 4; ++ks) {
                { const v4i16_t lo = vtr(vb_ + ks * 1024), up = vtr(vb_ + ks * 1024 + 512);
                  const bf16x8 vf = {lo[0], lo[1], lo[2], lo[3], up[0], up[1], up[2], up[3]};
                  o0 = __builtin_amdgcn_mfma_f32_32x32x16_bf16(vf, pf[ks], o0, 0, 0, 0); }
                { const v4i16_t lo = vtr(vb_ + 4096 + ks * 1024), up = vtr(vb_ + 4096 + ks * 1024 + 512);
                  const bf16x8 vf = {lo[0], lo[1], lo[2], lo[3], up[0], up[1], up[2], up[3]};
                  o1 = __builtin_amdgcn_mfma_f32_32x32x16_bf16(vf, pf[ks], o1, 0, 0, 0); }
            }
        }
        if (more) { *(LAS u32x4*)(lds + OFF_K + (buf ^ 1) * KTILE + kst) = kreg; *(LAS u32x4*)(lds + OFF_V + (buf ^ 1) * VTILE + vst) = vreg; }
        if (MODE == 1) { if (lane == 0) flags[buf * 8 + w] = alive ? 1 : 0; }
        __syncthreads();
        if (MODE == 1) { int any = 0;
#pragma unroll
            for (int k = 0; k < 8; ++k) any |= flags[buf * 8 + k];
            if (!any) break; }
    }
    float inv = 1.0f;
    if (MODE == 0) { const float l = lsum + __shfl_xor(lsum, 32); inv = 1.0f / l; }
    bf16_t* op = O + (rowbase + T0 + l32) * DM + OOFF + h * 64 + 4 * hi;
#pragma unroll
    for (int g4 = 0; g4 < 4; ++g4) {
        u32x2 a, c; a.x = cvtpk(o0[4 * g4] * inv, o0[4 * g4 + 1] * inv); a.y = cvtpk(o0[4 * g4 + 2] * inv, o0[4 * g4 + 3] * inv);
        c.x = cvtpk(o1[4 * g4] * inv, o1[4 * g4 + 1] * inv); c.y = cvtpk(o1[4 * g4 + 2] * inv, o1[4 * g4 + 3] * inv);
        *(u32x2*)(op + 8 * g4) = a; *(u32x2*)(op + 32 + 8 * g4) = c; }
#undef TILE_OF
}
}

constexpr size_t MiB = 1u << 20;
constexpr size_t WS_NSP = 1 * MiB;
constexpr size_t WS_W_ATT_IN = 2 * MiB;
constexpr size_t WS_W_ATT_OUT = 14 * MiB;
constexpr size_t WS_W_RG_IN = 18 * MiB;
constexpr size_t WS_W_RG_OUT = 26 * MiB;
constexpr size_t WS_W_RG_GATES = 30 * MiB;
constexpr size_t WS_W_GU = 32 * MiB;
constexpr size_t WS_W_DOWN = 76 * MiB;
constexpr size_t WS_SUMP = 98 * MiB, WS_SUMH = 99 * MiB;
constexpr size_t WS_S0 = 100 * MiB, WS_S1 = 132 * MiB, WS_S2 = 164 * MiB, WS_S3 = 196 * MiB, WS_END = 228 * MiB;

struct Args {
    const float* x; const float* attn_w_in; const float* attn_rel_bias; const float* attn_w_out; const float* rg_w_in; const float* rg_conv_w; const float* rg_conv_b;
    const float* rg_w_a; const float* rg_b_a; const float* rg_w_i; const float* rg_b_i; const float* rg_lambda; const float* rg_w_out;
    const float* norm_mix_pre; const float* norm_mix_post; const float* norm_ffn_pre; const float* norm_ffn_post;
    const float* ffn_w_gate; const float* ffn_w_up; const float* ffn_w_down;
    float* out; unsigned char* ws;
};

#define XB_TMO      128
#define XB_XCNT(j)  (256  + 64 * (j))
#define XB_XSUB(j)  (1280 + 64 * (j))
#define XB_XGEN(j)  (2304 + 64 * (j))
#define XB_TOP      3328
#define XB_TOPGEN   3392
#define XCD_BAR_WORDS 3456
#define XB_SPIN_CAP (1u << 18)

__device__ __forceinline__ unsigned xb_ld(unsigned* p)              { return __hip_atomic_load(p, __ATOMIC_RELAXED, __HIP_MEMORY_SCOPE_AGENT); }
__device__ __forceinline__ unsigned xb_add(unsigned* p, unsigned v) { return __hip_atomic_fetch_add(p, v, __ATOMIC_RELAXED, __HIP_MEMORY_SCOPE_AGENT); }
__device__ __forceinline__ unsigned xb_xcc_id() { return (unsigned)__builtin_amdgcn_s_getreg((3 << 11) | 20) & 0xFu; }
#define XB_SPIN(cond, bar) do { unsigned _sp = 0; while (cond) { __builtin_amdgcn_s_sleep(1); \
    if ((++_sp & 255u) == 0u) { if (xb_ld(&(bar)[XB_TMO])) break; if (_sp > XB_SPIN_CAP) { atomicAdd(&(bar)[XB_TMO], 1u); break; } } } } while (0)

struct XcdBarrier {
    unsigned* bar; unsigned x;
    volatile LAS unsigned* st;
};

__device__ __forceinline__ XcdBarrier xcd_barrier_post(unsigned* bar, volatile LAS unsigned* st) {
    XcdBarrier b; b.bar = bar; b.x = xb_xcc_id(); b.st = st;
    if (threadIdx.x == 0) (void)xb_add(&bar[XB_XCNT(b.x)], 1u);
    return b;
}
__device__ __forceinline__ void xcd_barrier_complete(unsigned* bar, unsigned x, unsigned& nloc, unsigned& nx) {
    const unsigned G = gridDim.x * gridDim.y * gridDim.z;
    unsigned sum, cnt, mine, sp = 0u;
    for (;;) {
        sum = 0u; cnt = 0u; mine = 0u;
#pragma unroll
        for (unsigned j = 0; j < 16; ++j) { const unsigned c = xb_ld(&bar[XB_XCNT(j)]); sum += c; cnt += (c > 0u) ? 1u : 0u; mine = (j == x) ? c : mine; }
        if (sum == G) break;
        __builtin_amdgcn_s_sleep(1);
        if ((++sp & 255u) == 0u) { if (xb_ld(&bar[XB_TMO])) break; if (sp > XB_SPIN_CAP) { atomicAdd(&bar[XB_TMO], 1u); break; } }
    }
    nloc = mine > 0u ? mine : 1u; nx = cnt > 0u ? cnt : 1u;
}

__device__ __forceinline__ void xcd_barrier(const XcdBarrier& b) {
    asm volatile("s_waitcnt vmcnt(0)" ::: "memory");
    __syncthreads();
    if (threadIdx.x == 0) {
        unsigned* bar = b.bar;
        __builtin_amdgcn_s_waitcnt(0);
        unsigned nloc = b.st[0], nx = b.st[1];
        if (nloc == 0u) { xcd_barrier_complete(bar, b.x, nloc, nx); b.st[0] = nloc; b.st[1] = nx; }
        const unsigned old = xb_add(&bar[XB_XSUB(b.x)], 1u);
        const unsigned gen = old / nloc;
        if (old + 1u == (gen + 1u) * nloc) {
            __builtin_amdgcn_fence(__ATOMIC_RELEASE, "agent");
            asm volatile("s_waitcnt vmcnt(0)" ::: "memory");
            const unsigned og = xb_add(&bar[XB_TOP], 1u);
            const unsigned tg = og / nx;
            if (og + 1u == (tg + 1u) * nx) xb_add(&bar[XB_TOPGEN], 1u);
            else XB_SPIN(xb_ld(&bar[XB_TOPGEN]) == tg, bar);
            __builtin_amdgcn_fence(__ATOMIC_ACQUIRE, "agent");
            xb_add(&bar[XB_XGEN(b.x)], 1u);
            asm volatile("s_waitcnt vmcnt(0)" ::: "memory");
        } else {
            XB_SPIN(xb_ld(&bar[XB_XGEN(b.x)]) == gen, bar);
            __builtin_amdgcn_fence(__ATOMIC_ACQUIRE, "agent");
            asm volatile("s_waitcnt vmcnt(0)" ::: "memory");
        }
    }
    __syncthreads();
}


__device__ __forceinline__ unsigned long long karg_ld(int off) {
    auto kp = __builtin_amdgcn_kernarg_segment_ptr();
    unsigned long long r;
    asm volatile("s_load_dwordx2 %0, %1, %2\n\ts_waitcnt lgkmcnt(0)" : "=s"(r) : "s"(kp), "n"(off));
    return r;
}
#define KA(field) ((decltype(Args::field))karg_ld((int)__builtin_offsetof(Args, field)))
#define WSB(off) ((bf16_t*)(KA(ws) + (off)))
__device__ __forceinline__ float wave_sum(float v) {
#pragma unroll
    for (int o = 1; o < 64; o <<= 1) v += __shfl_xor(v, o);
    return v;
}
__device__ __forceinline__ void transpose_item(const float* __restrict__ W, int K, int N, bf16_t* __restrict__ WT, int base, bool inter, LAS float* scr, int item, int lane) {
    const int nblk = N / 32, kb = item / nblk, nb = item % nblk, k0 = 64 * kb, n0 = 32 * nb;
#pragma unroll 8
    for (int i = 0; i < 32; ++i) { const int kk = 2 * i + (lane >> 5); scr[kk * 33 + (lane & 31)] = W[(size_t)(k0 + kk) * N + n0 + (lane & 31)]; }
    asm volatile("s_waitcnt lgkmcnt(0)" ::: "memory");
    const int c = lane & 7;
    const int drow0 = base + (inter ? ((n0 >> 7) * 256 + (n0 & 127)) : n0);
#pragma unroll
    for (int j = 0; j < 4; ++j) { const int nn = (lane >> 3) + 8 * j; const LAS float* s = scr + (8 * c) * 33 + nn;
        u32x4 o; o.x = cvtpk(s[0 * 33], s[1 * 33]); o.y = cvtpk(s[2 * 33], s[3 * 33]); o.z = cvtpk(s[4 * 33], s[5 * 33]); o.w = cvtpk(s[6 * 33], s[7 * 33]);
        *(u32x4*)(WT + (size_t)(drow0 + nn) * K + k0 + 8 * c) = o; }
    asm volatile("s_waitcnt lgkmcnt(0)" ::: "memory");
}

__device__ __forceinline__ void rowpass(const void* xin, bool xin_bf, const bf16_t* mrow, const float* __restrict__ gpost, void* xout, bool xout_bf,
                                        const float* __restrict__ gpre, bf16_t* hout, int gw, int NGW, int lane) {
    f32x4 gp[4], gq[4];
#pragma unroll
    for (int j = 0; j < 4; ++j) { gp[j] = mrow ? ((const f32x4*)gpost)[lane + 64 * j] : (f32x4){0.f, 0.f, 0.f, 0.f}; gq[j] = gpre ? ((const f32x4*)gpre)[lane + 64 * j] : (f32x4){0.f, 0.f, 0.f, 0.f}; }
    for (int row0 = gw; row0 < M; row0 += 2 * NGW) {
        f32x4 v[2][4], mv[2][4];
#pragma unroll
        for (int k = 0; k < 2; ++k) { const size_t row = (size_t)row0 + (size_t)k * NGW;
            if (xin_bf) {
#pragma unroll
                for (int j = 0; j < 4; ++j) { const u32x2 t = ((const u32x2*)((const bf16_t*)xin + row * DM))[lane + 64 * j]; v[k][j] = (f32x4){bf_lo(t.x), bf_hi(t.x), bf_lo(t.y), bf_hi(t.y)}; }
            } else {
#pragma unroll
                for (int j = 0; j < 4; ++j) v[k][j] = ((const f32x4*)((const float*)xin + row * DM))[lane + 64 * j];
            }
            if (mrow) {
#pragma unroll
                for (int j = 0; j < 4; ++j) { const u32x2 t = ((const u32x2*)(mrow + row * DM))[lane + 64 * j]; mv[k][j] = (f32x4){bf_lo(t.x), bf_hi(t.x), bf_lo(t.y), bf_hi(t.y)}; }
            } }
#pragma unroll
        for (int k = 0; k < 2; ++k) { const size_t row = (size_t)row0 + (size_t)k * NGW;
            if (mrow) { float s = 0.f;
#pragma unroll
                for (int j = 0; j < 4; ++j) s += (mv[k][j].x * mv[k][j].x + mv[k][j].y * mv[k][j].y) + (mv[k][j].z * mv[k][j].z + mv[k][j].w * mv[k][j].w);
                const float sc = 1.0f / sqrtf(wave_sum(s) * (1.0f / DM) + RMS_EPS);
#pragma unroll
                for (int j = 0; j < 4; ++j) v[k][j] = v[k][j] + mv[k][j] * sc * gp[j];
            }
            if (xout) {
                if (xout_bf) {
#pragma unroll
                    for (int j = 0; j < 4; ++j) { u32x2 t; t.x = cvtpk(v[k][j].x, v[k][j].y); t.y = cvtpk(v[k][j].z, v[k][j].w); ((u32x2*)((bf16_t*)xout + row * DM))[lane + 64 * j] = t;
                        v[k][j] = (f32x4){bf_lo(t.x), bf_hi(t.x), bf_lo(t.y), bf_hi(t.y)}; }
                } else {
#pragma unroll
                    for (int j = 0; j < 4; ++j) ((f32x4*)((float*)xout + row * DM))[lane + 64 * j] = v[k][j];
                }
            }
            if (gpre) {
                float s2 = 0.f;
#pragma unroll
                for (int j = 0; j < 4; ++j) s2 += (v[k][j].x * v[k][j].x + v[k][j].y * v[k][j].y) + (v[k][j].z * v[k][j].z + v[k][j].w * v[k][j].w);
                const float r = 1.0f / sqrtf(wave_sum(s2) * (1.0f / DM) + RMS_EPS);
#pragma unroll
                for (int j = 0; j < 4; ++j) { const f32x4 hv = v[k][j] * r * gq[j]; u32x2 t; t.x = cvtpk(hv.x, hv.y); t.y = cvtpk(hv.z, hv.w); ((u32x2*)(hout + row * DM))[lane + 64 * j] = t; }
            }
        }
    }
}

__device__ __forceinline__ void conv_phase(const bf16_t* __restrict__ xr, bf16_t* __restrict__ xc, const float* __restrict__ cw, const float* __restrict__ cbp, int gt, int nthr) {
    for (int it = gt; it < 1024 * 128; it += nthr) {
        const int cgp = it & 127, run = it >> 7, c0 = cgp * 8, r0 = run * 16;
        float cwt[4][8], cb[8];
#pragma unroll
        for (int t = 0; t < 4; ++t)
#pragma unroll
            for (int e = 0; e < 8; ++e) cwt[t][e] = cw[(size_t)t * DM + c0 + e];
#pragma unroll
        for (int e = 0; e < 8; ++e) cb[e] = cbp[c0 + e];
        float hst[3][8];
        const bool first = (r0 % SEQ) == 0;
#pragma unroll
        for (int t = 0; t < 3; ++t) { u32x4 q = {0u, 0u, 0u, 0u}; if (!first) q = *(const u32x4*)(xr + (size_t)(r0 - 3 + t) * DM + c0);
            hst[t][0] = bf_lo(q.x); hst[t][1] = bf_hi(q.x); hst[t][2] = bf_lo(q.y); hst[t][3] = bf_hi(q.y); hst[t][4] = bf_lo(q.z); hst[t][5] = bf_hi(q.z); hst[t][6] = bf_lo(q.w); hst[t][7] = bf_hi(q.w); }
#pragma unroll 4
        for (int r = 0; r < 16; ++r) {
            const u32x4 q = *(const u32x4*)(xr + (size_t)(r0 + r) * DM + c0);
            float cur[8] = {bf_lo(q.x), bf_hi(q.x), bf_lo(q.y), bf_hi(q.y), bf_lo(q.z), bf_hi(q.z), bf_lo(q.w), bf_hi(q.w)};
            float ov[8];
#pragma unroll
            for (int e = 0; e < 8; ++e) { ov[e] = cb[e] + cwt[0][e] * hst[0][e] + cwt[1][e] * hst[1][e] + cwt[2][e] * hst[2][e] + cwt[3][e] * cur[e];
                hst[0][e] = hst[1][e]; hst[1][e] = hst[2][e]; hst[2][e] = cur[e]; }
            u32x4 o; o.x = cvtpk(ov[0], ov[1]); o.y = cvtpk(ov[2], ov[3]); o.z = cvtpk(ov[4], ov[5]); o.w = cvtpk(ov[6], ov[7]);
            *(u32x4*)(xc + (size_t)(r0 + r) * DM + c0) = o;
        }
    }
}
__device__ __forceinline__ void scan1_phase(const bf16_t* __restrict__ LA, const bf16_t* __restrict__ U, float* __restrict__ sumP, float* __restrict__ sumH, int gt, int nthr) {
    for (int it = gt; it < 256 * 512; it += nthr) {
        const int cp = it & 511, ch = it >> 9; const size_t base = (size_t)ch * 64 * DM + cp * 2;
        float P0 = 1.f, P1 = 1.f, H0 = 0.f, H1 = 0.f;
#pragma unroll 8
        for (int r = 0; r < 64; ++r) { const unsigned la = *(const unsigned*)(LA + base + (size_t)r * DM), uu = *(const unsigned*)(U + base + (size_t)r * DM);
            const float a0 = fast_exp(bf_lo(la)), a1 = fast_exp(bf_hi(la));
            P0 *= a0; P1 *= a1; H0 = a0 * H0 + bf_lo(uu); H1 = a1 * H1 + bf_hi(uu); }
        *(f32x2*)(sumP + (size_t)ch * DM + cp * 2) = (f32x2){P0, P1}; *(f32x2*)(sumH + (size_t)ch * DM + cp * 2) = (f32x2){H0, H1};
    }
}
__device__ __forceinline__ void scan2_phase(const bf16_t* __restrict__ LA, const bf16_t* __restrict__ U, bf16_t* GT, const float* __restrict__ sumP, const float* __restrict__ sumH, int gt, int nthr) {
    for (int it = gt; it < 256 * 512; it += nthr) {
        const int cp = it & 511, ch = it >> 9, c = ch & 127, ch0 = ch - c; const size_t base = (size_t)ch * 64 * DM + cp * 2;
        float H0 = 0.f, H1 = 0.f;
#pragma unroll 8
        for (int k = 0; k < c; ++k) { const f32x2 p = *(const f32x2*)(sumP + (size_t)(ch0 + k) * DM + cp * 2), hh = *(const f32x2*)(sumH + (size_t)(ch0 + k) * DM + cp * 2);
            H0 = p.x * H0 + hh.x; H1 = p.y * H1 + hh.y; }
#pragma unroll 8
        for (int r = 0; r < 64; ++r) { const unsigned la = *(const unsigned*)(LA + base + (size_t)r * DM), uu = *(const unsigned*)(U + base + (size_t)r * DM), gg = *(const unsigned*)(GT + base + (size_t)r * DM);
            const float a0 = fast_exp(bf_lo(la)), a1 = fast_exp(bf_hi(la));
            H0 = a0 * H0 + bf_lo(uu); H1 = a1 * H1 + bf_hi(uu);
            *(unsigned*)(GT + base + (size_t)r * DM) = cvtpk(H0 * bf_lo(gg), H1 * bf_hi(gg)); }
    }
}

#ifndef PROBE
#define PROBE 0
#endif
constexpr int NTHREADS = 512, NWAVES = 8;
constexpr int LDS_BYTES = 147456;

__global__ void __launch_bounds__(NTHREADS, 2) mega_fwd(Args a) {
    extern __shared__ __attribute__((aligned(16))) unsigned char lds_raw[];
    LAS unsigned char* lds = (LAS unsigned char*)lds_raw;
    cg::grid_group grid = cg::this_grid();
    const int tid = threadIdx.x, lane = tid & 63; const int wave = __builtin_amdgcn_readfirstlane(tid >> 6);
    const int G = gridDim.x, bx = blockIdx.x;
    const int vcu = (G % 8 == 0) ? (bx % 8) * (G / 8) + bx / 8 : bx;
    const int gw = vcu * NWAVES + wave, NGW = G * NWAVES;
    volatile LAS unsigned* bst = (volatile LAS unsigned*)(lds + 131072 + 64);
    if (tid < 2) bst[tid] = 0u;
    __syncthreads();
    const XcdBarrier xbar = xcd_barrier_post((unsigned*)KA(ws), bst);
#define S0 WSB(WS_S0)
#define S1 WSB(WS_S1)
#define S2 WSB(WS_S2)
#define S3 WSB(WS_S3)
#define WSP KA(ws)

    {
        LAS float* scr = (LAS float*)(lds + wave * 16384);
        unsigned char* const wsl = WSP;
        int off = 0;
        for (int rep = 0; rep < ((PROBE & 4) ? 2 : 1); ++rep)
        for (int job = 0; job < 36; ++job) {
            const float* W; int K, N, base = 0; bool inter = false; bf16_t* WT;
            if (job < 2) { W = KA(attn_w_in) + (size_t)job * DM * QKVW; K = DM; N = QKVW; WT = (bf16_t*)(wsl + WS_W_ATT_IN) + (size_t)job * QKVW * DM; }
            else if (job < 4) { const int j = job - 2; W = KA(attn_w_out) + (size_t)j * DM * DM; K = DM; N = DM; WT = (bf16_t*)(wsl + WS_W_ATT_OUT) + (size_t)j * DM * DM; }
            else if (job < 6) { const int j = job - 4; W = KA(rg_w_in) + (size_t)j * DM * 2048; K = DM; N = 2048; WT = (bf16_t*)(wsl + WS_W_RG_IN) + (size_t)j * 2048 * DM; }
            else if (job < 8) { const int j = job - 6; W = KA(rg_w_out) + (size_t)j * DM * DM; K = DM; N = DM; WT = (bf16_t*)(wsl + WS_W_RG_OUT) + (size_t)j * DM * DM; }
            else if (job < 24) { const int idx = job - 8, j = idx >> 3, which = (idx >> 2) & 1, blk = idx & 3;
                W = (which ? KA(rg_w_i) : KA(rg_w_a)) + (size_t)(j * 4 + blk) * 65536; K = 256; N = 256; WT = (bf16_t*)(wsl + WS_W_RG_GATES) + (size_t)j * 2048 * 256; base = blk * 512 + which * 128; inter = true; }
            else if (job < 28) { const int l = job - 24; W = KA(ffn_w_gate) + (size_t)l * DM * DFF; K = DM; N = DFF; WT = (bf16_t*)(wsl + WS_W_GU) + (size_t)l * 2 * DFF * DM; base = 0; inter = true; }
            else if (job < 32) { const int l = job - 28; W = KA(ffn_w_up) + (size_t)l * DM * DFF; K = DM; N = DFF; WT = (bf16_t*)(wsl + WS_W_GU) + (size_t)l * 2 * DFF * DM; base = 128; inter = true; }
            else { const int l = job - 32; W = KA(ffn_w_down) + (size_t)l * DFF * DM; K = DFF; N = DM; WT = (bf16_t*)(wsl + WS_W_DOWN) + (size_t)l * DM * DFF; }
            const int nitems = (K / 64) * (N / 32);
            int first = gw - off; first %= NGW; if (first < 0) first += NGW;
            for (int it = first; it < nitems; it += NGW) transpose_item(W, K, N, WT, base, inter, scr, it, lane);
            off = (off + nitems) % NGW;
        }
    }
    { float* cst = (float*)(WSP + WS_NSP); const int gt = vcu * NTHREADS + tid; if (gt < 2 * DM) { const int jj = gt >> 10, c = gt & 1023;
        cst[jj * 3072 + c] = KA(rg_b_a)[gt]; cst[jj * 3072 + 1024 + c] = KA(rg_b_i)[gt]; cst[jj * 3072 + 2048 + c] = -8.0f * log1pf(expf(-KA(rg_lambda)[gt])); } }
    rowpass(KA(x), false, nullptr, nullptr, nullptr, false, KA(norm_mix_pre), S0, gw, NGW, lane);
    grid.sync();

    for (int step = 0; step <= DEPTH * 10; ++step) {
        const int layer = step / 10, sub = step - layer * 10, j = layer >> 1; const bool is_attn = (layer & 1) == 0, fin = (step == DEPTH * 10);
        if (!fin && is_attn && (sub == 3 || sub == 4 || sub == 5)) continue;
        if (step == 0) continue;
        if (fin || sub == 0 || sub == 7) {
            const void* xin; bool xin_bf = true; const bf16_t* mrow; const float* gpost; void* xout; bool xout_bf = true; const float* gpre; bf16_t* hout = S0;
            bf16_t* const XL = (bf16_t*)(WSP + WS_W_GU);
            if (fin) { xin = XL; mrow = S0; gpost = KA(norm_ffn_post) + (size_t)(DEPTH - 1) * DM; xout = KA(out); xout_bf = false; gpre = nullptr; hout = nullptr; }
            else if (sub == 0) { xin = KA(out); mrow = S0; gpost = KA(norm_ffn_post) + (size_t)(layer - 1) * DM; xout = KA(out); gpre = KA(norm_mix_pre) + (size_t)layer * DM; }
            else { if (layer == 0) { xin = KA(x); xin_bf = false; } else xin = KA(out);
                   mrow = is_attn ? S1 : S2; gpost = KA(norm_mix_post) + (size_t)layer * DM; xout = (layer == DEPTH - 1) ? (void*)XL : (void*)KA(out); gpre = KA(norm_ffn_pre) + (size_t)layer * DM; }
            rowpass(xin, xin_bf, mrow, gpost, xout, xout_bf, gpre, hout, gw, NGW, lane);
        } else if (sub == 1 || sub == 3 || sub == 6 || sub == 8 || sub == 9) {
            unsigned oA, oB, oP0, oP1 = 0; int N, K = DM, lda = DM, ldb = DM, ash = 0, ael = 0, mode = pg8::EPI_STORE, ldc = DM;
            if (sub == 1) { oA = WS_S0; if (is_attn) { oB = WS_W_ATT_IN + j * (QKVW * DM * 2); N = QKVW; oP0 = WS_S1; ldc = QKVW; }
                            else { oB = WS_W_RG_IN + j * (2048 * DM * 2); N = 2048; mode = pg8::EPI_RECIN; oP0 = WS_S1; oP1 = WS_S2; } }
            else if (sub == 3) { oA = WS_S3; oB = WS_W_RG_GATES + j * (2048 * 256 * 2); N = 2048; K = 256; ldb = 256; ash = 1; ael = 256; mode = pg8::EPI_GATES; oP0 = 0; oP1 = WS_NSP + j * (3072 * 4); }
            else if (sub == 6) { N = DM; if (is_attn) { oA = WS_S0; oB = WS_W_ATT_OUT + j * (DM * DM * 2); oP0 = WS_S1; } else { oA = WS_S1; oB = WS_W_RG_OUT + j * (DM * DM * 2); oP0 = WS_S2; } }
            else if (sub == 8) { oA = WS_S0; oB = WS_W_GU + layer * (2 * DFF * DM * 2); N = 2 * DFF; mode = pg8::EPI_SWIGLU; oP0 = WS_S1; ldc = DFF; }
            else { oA = WS_S1; oB = WS_W_DOWN + layer * (DM * DFF * 2); N = DM; K = DFF; lda = DFF; ldb = DFF; oP0 = WS_S0; }
            unsigned char* const wsl = WSP;
            pg8::Gemm g{(const bf16_t*)(wsl + oA), (const bf16_t*)(wsl + oB), K, lda, ldb, ash, ael}; pg8::StaticOrder S; S.init(M, N, G, bx);
            pg8::Epi E{mode, wsl + oP0, wsl + oP1, ldc};
            for (int rep = 0; rep < ((PROBE & 1) ? 2 : 1); ++rep) pg8::gemm_phase<true>(lds, g, S, E);
        } else if (sub == 2) {
            if (is_attn) {
                for (int rep = 0; rep < ((PROBE & 2) ? 2 : 1); ++rep)
                for (int uu = vcu; uu < 1024; uu += G) {
                    const int uidx = uu & 511;
                    const int qb = uidx & 31, hh = (uidx >> 5) & 7, bb = uidx >> 8;
                    if (uu < 512) att::unit<0>(S1, S0, bb, hh, qb, KA(attn_rel_bias) + (size_t)(j * 8 + hh) * 513, lds);
                    else att::unit<1>(S1, S0, bb, hh, qb, nullptr, lds);
                }
            } else conv_phase(S2, S3, KA(rg_conv_w) + (size_t)j * 4 * DM, KA(rg_conv_b) + (size_t)j * DM, vcu * NTHREADS + tid, G * NTHREADS);
        } else if (sub == 4) scan1_phase(S2, S0, (float*)(WSP + WS_SUMP), (float*)(WSP + WS_SUMH), vcu * NTHREADS + tid, G * NTHREADS);
        else scan2_phase(S2, S0, S1, (const float*)(WSP + WS_SUMP), (const float*)(WSP + WS_SUMH), vcu * NTHREADS + tid, G * NTHREADS);
        if (!fin) { xcd_barrier(xbar); if (PROBE & 8) xcd_barrier(xbar); }
    }
}

#undef WSP
#undef S0
#undef S1
#undef S2
#undef S3
extern "C" void kernel_launch(void* const* d_in, const int* in_sizes, int n_in, void* d_out, int out_size, void* d_ws, size_t ws_size, hipStream_t stream) {
    static int grid = 0;
    if (grid == 0) {
        if (n_in != 20 || in_sizes[0] != M * DM || out_size != M * DM || ws_size < WS_END) { fprintf(stderr, "kernel_launch: unexpected shapes (n_in %d, in0 %d, out %d, ws %zu); nothing launched\n", n_in, n_in > 0 ? in_sizes[0] : -1, out_size, ws_size); grid = -1; return; }
        int dev = 0, cus = 0, per_cu = 0;
        if (hipGetDevice(&dev) != hipSuccess || hipDeviceGetAttribute(&cus, hipDeviceAttributeMultiprocessorCount, dev) != hipSuccess) { grid = -1; return; }
        if (hipFuncSetAttribute((const void*)mega_fwd, hipFuncAttributeMaxDynamicSharedMemorySize, LDS_BYTES) != hipSuccess) { fprintf(stderr, "kernel_launch: hipFuncSetAttribute failed\n"); grid = -1; return; }
        if (hipOccupancyMaxActiveBlocksPerMultiprocessor(&per_cu, (const void*)mega_fwd, NTHREADS, LDS_BYTES) != hipSuccess || per_cu < 1) { fprintf(stderr, "kernel_launch: occupancy query says %d\n", per_cu); per_cu = 1; }
        (void)hipGetLastError();
        grid = cus * 1;
    }
    if (grid < 0) return;
    if (hipMemsetAsync(d_ws, 0, 16384, stream) != hipSuccess) { fprintf(stderr, "kernel_launch: memset of the barrier words failed\n"); return; }
    Args a{};
    a.x = (const float*)d_in[0]; a.attn_w_in = (const float*)d_in[1]; a.attn_rel_bias = (const float*)d_in[2]; a.attn_w_out = (const float*)d_in[3];
    a.rg_w_in = (const float*)d_in[4]; a.rg_conv_w = (const float*)d_in[5]; a.rg_conv_b = (const float*)d_in[6]; a.rg_w_a = (const float*)d_in[7]; a.rg_b_a = (const float*)d_in[8];
    a.rg_w_i = (const float*)d_in[9]; a.rg_b_i = (const float*)d_in[10]; a.rg_lambda = (const float*)d_in[11]; a.rg_w_out = (const float*)d_in[12];
    a.norm_mix_pre = (const float*)d_in[13]; a.norm_mix_post = (const float*)d_in[14]; a.norm_ffn_pre = (const float*)d_in[15]; a.norm_ffn_post = (const float*)d_in[16];
    a.ffn_w_gate = (const float*)d_in[17]; a.ffn_w_up = (const float*)d_in[18]; a.ffn_w_down = (const float*)d_in[19];
    a.out = (float*)d_out; a.ws = (unsigned char*)d_ws;
    void* args[] = {&a};
    hipError_t e = hipLaunchCooperativeKernel((const void*)mega_fwd, dim3(grid), dim3(NTHREADS), args, LDS_BYTES, stream);
    if (e != hipSuccess) fprintf(stderr, "kernel_launch: cooperative launch failed: %s (grid %d)\n", hipGetErrorString(e), grid);
}
```

```cpp
#include <hip/hip_runtime.h>
#include <hip/hip_cooperative_groups.h>
#include <cstdio>
#include <cstdint>
namespace cg = cooperative_groups;

#define LAS __attribute__((address_space(3)))
typedef unsigned short bf16_t;
typedef short bf16x8 __attribute__((ext_vector_type(8)));
typedef float f32x4 __attribute__((ext_vector_type(4)));
typedef float f32x2 __attribute__((ext_vector_type(2)));
typedef float f32x16 __attribute__((ext_vector_type(16)));
typedef unsigned u32x4 __attribute__((ext_vector_type(4)));
typedef unsigned u32x2 __attribute__((ext_vector_type(2)));
typedef __bf16 bf16x2_t __attribute__((ext_vector_type(2)));

constexpr int BATCH = 2, SEQ = 8192, DM = 1024, DEPTH = 4, M = BATCH * SEQ;
constexpr int DFF = 2816, QKVW = 3072;
constexpr float RMS_EPS = 1e-6f;
constexpr float LOG2E = 1.4426950408889634f;

__device__ __forceinline__ unsigned cvtpk(float lo, float hi) { f32x2 v = {lo, hi}; bf16x2_t b = __builtin_convertvector(v, bf16x2_t); return __builtin_bit_cast(unsigned, b); }
__device__ __forceinline__ float bf_lo(unsigned w) { return __uint_as_float(w << 16); }
__device__ __forceinline__ float bf_hi(unsigned w) { return __uint_as_float(w & 0xffff0000u); }
__device__ __forceinline__ float fast_exp(float x) { return __builtin_amdgcn_exp2f(x * LOG2E); }
__device__ __forceinline__ float fast_sigmoid(float x) { return __builtin_amdgcn_rcpf(1.0f + fast_exp(-x)); }
__device__ __forceinline__ float silu_f(float x) { return x * fast_sigmoid(x); }
__device__ __forceinline__ float gelu_tanh_f(float x) { const float t = 1.5957691216057308f * (x + 0.044715f * x * x * x); return x * fast_sigmoid(t); }

namespace pg8 {
constexpr int BM = 256, BK = 64, HALF = 128, HTB = HALF * BK * 2, STAGE_BYTES = 8 * HTB, NXCD = 8, WGM = 8;

__host__ __device__ __forceinline__ int lds_byte(int r, int c) { const int st = (r >> 4) * 2 + (c >> 5), rr = r & 15, cc = c & 31, ob = rr * 64 + cc * 2; return st * 1024 + (ob ^ (((ob >> 9) & 1) << 5)); }
__host__ __device__ __forceinline__ void stage_rc(int b, int& R, int& C) { const int st = b / 1024, sb = b % 1024, swz = sb ^ (((sb >> 9) & 1) << 5); R = (st >> 1) * 16 + swz / 64; C = (st & 1) * 32 + (swz % 64) / 2; }
__host__ __device__ __forceinline__ int perm32(int rho) { const int n = rho >> 4, i = rho & 15; return 8 * (i >> 2) + 4 * n + (i & 3); }

struct Unit { int pm, pn; };
struct Gemm { const bf16_t* A; const bf16_t* Bt; int K, lda, ldb, apn_shift, apn_elems; };

struct StaticOrder {
    int nM, nN, nwg, G, c;
    __host__ __device__ void init(int M_, int N_, int G_, int c_) { nM = M_ / BM; nN = N_ / BM; nwg = nM * nN; G = G_; c = c_; }
    __host__ __device__ bool next(int i, Unit& u) const {
        const long L = (long)i * G + c; if (L >= nwg) return false;
        int wgid = (int)L; { const int q = nwg / NXCD, r = nwg % NXCD, xcd = wgid % NXCD, off = wgid / NXCD; wgid = (xcd < r ? xcd * (q + 1) : r * (q + 1) + (xcd - r) * q) + off; }
        const int nig = WGM * nN, gid = wgid / nig, fm = gid * WGM, gsz = (nM - fm) < WGM ? (nM - fm) : WGM;
        u.pm = fm + ((wgid % nig) % gsz); u.pn = (wgid % nig) / gsz; return true;
    }
};

enum { EPI_STORE = 0, EPI_SWIGLU = 1, EPI_RECIN = 2, EPI_GATES = 3 };

struct Epi {
    int mode; unsigned char* p0; unsigned char* p1; int ldc;
    __device__ __forceinline__ void operator()(const f32x4 (&acc)[2][2][4][2], const Unit& u, int wr, int wc, int fr, int fq) const {
        const int row0 = u.pm * BM + wr * 64 + fr;
        if (mode == EPI_STORE) {
            bf16_t* O = (bf16_t*)p0; const int col0 = u.pn * BM + wc * 32 + 8 * fq;
#pragma unroll
            for (int ai = 0; ai < 2; ++ai)
#pragma unroll
                for (int m = 0; m < 4; ++m) { bf16_t* rowp = O + (size_t)(row0 + ai * HALF + m * 16) * ldc + col0;
#pragma unroll
                    for (int bj = 0; bj < 2; ++bj) { const f32x4 v0 = acc[ai][bj][m][0], v1 = acc[ai][bj][m][1];
                        u32x4 w; w.x = cvtpk(v0[0], v0[1]); w.y = cvtpk(v0[2], v0[3]); w.z = cvtpk(v1[0], v1[1]); w.w = cvtpk(v1[2], v1[3]);
                        *(u32x4*)(rowp + bj * HALF) = w; } }
        } else if (mode == EPI_SWIGLU) {
            bf16_t* O = (bf16_t*)p0; const int col0 = u.pn * HALF + wc * 32 + 8 * fq;
#pragma unroll
            for (int ai = 0; ai < 2; ++ai)
#pragma unroll
                for (int m = 0; m < 4; ++m) { bf16_t* rowp = O + (size_t)(row0 + ai * HALF + m * 16) * ldc + col0;
                    const f32x4 g0 = acc[ai][0][m][0], g1 = acc[ai][0][m][1], u0 = acc[ai][1][m][0], u1 = acc[ai][1][m][1];
                    u32x4 w; w.x = cvtpk(silu_f(g0[0]) * u0[0], silu_f(g0[1]) * u0[1]); w.y = cvtpk(silu_f(g0[2]) * u0[2], silu_f(g0[3]) * u0[3]);
                    w.z = cvtpk(silu_f(g1[0]) * u1[0], silu_f(g1[1]) * u1[1]); w.w = cvtpk(silu_f(g1[2]) * u1[2], silu_f(g1[3]) * u1[3]);
                    *(u32x4*)rowp = w; }
        } else if (mode == EPI_RECIN) {
            const bool isg = u.pn < 4; bf16_t* base = (bf16_t*)(isg ? p0 : p1);
            const int col0 = (u.pn & 3) * BM + wc * 32 + 8 * fq;
#pragma unroll
            for (int ai = 0; ai < 2; ++ai)
#pragma unroll
                for (int m = 0; m < 4; ++m) { bf16_t* rowp = base + (size_t)(row0 + ai * HALF + m * 16) * DM + col0;
#pragma unroll
                    for (int bj = 0; bj < 2; ++bj) { f32x4 v0 = acc[ai][bj][m][0], v1 = acc[ai][bj][m][1];
                        if (isg) {
#pragma unroll
                            for (int e = 0; e < 4; ++e) { v0[e] = gelu_tanh_f(v0[e]); v1[e] = gelu_tanh_f(v1[e]); } }
                        u32x4 w; w.x = cvtpk(v0[0], v0[1]); w.y = cvtpk(v0[2], v0[3]); w.z = cvtpk(v1[0], v1[1]); w.w = cvtpk(v1[2], v1[3]);
                        *(u32x4*)(rowp + bj * HALF) = w; } }
        } else {
            const int ch0 = u.pn * HALF + wc * 32 + 8 * fq; const float* cst = (const float*)p1;
            const bf16_t* XC = (const bf16_t*)(p0 + (196u << 20)); bf16_t* LA = (bf16_t*)(p0 + (164u << 20)); bf16_t* U = (bf16_t*)(p0 + (100u << 20));
#pragma unroll
            for (int n = 0; n < 2; ++n) {
                const f32x4 vba = *(const f32x4*)(cst + ch0 + 4 * n), vbi = *(const f32x4*)(cst + 1024 + ch0 + 4 * n), nsp = *(const f32x4*)(cst + 2048 + ch0 + 4 * n);
#pragma unroll
                for (int ai = 0; ai < 2; ++ai)
#pragma unroll
                    for (int m = 0; m < 4; ++m) { const size_t off = (size_t)(row0 + ai * HALF + m * 16) * DM + ch0 + 4 * n;
                        const u32x2 xw = *(const u32x2*)(XC + off);
                        const float xc[4] = {bf_lo(xw.x), bf_hi(xw.x), bf_lo(xw.y), bf_hi(xw.y)};
                        float la[4], uu[4];
#pragma unroll
                        for (int e = 0; e < 4; ++e) { const float pa = acc[ai][0][m][n][e] + vba[e], pi = acc[ai][1][m][n][e] + vbi[e];
                            const float r = fast_sigmoid(pa), ig = fast_sigmoid(pi);
                            la[e] = nsp[e] * r;
                            const float x2 = 2.0f * la[e];
                            const float ser = -x2 * (1.0f + x2 * (0.5f + x2 * (0.16666667f + x2 * (0.041666668f + x2 * (0.008333334f + x2 * (0.0013888889f + x2 * 0.0001984127f))))));
                            const float om = x2 > -0.3f ? ser : 1.0f - fast_exp(x2);
                            uu[e] = __builtin_amdgcn_sqrtf(om) * ig * xc[e]; }
                        u32x2 w1, w2; w1.x = cvtpk(la[0], la[1]); w1.y = cvtpk(la[2], la[3]); w2.x = cvtpk(uu[0], uu[1]); w2.y = cvtpk(uu[2], uu[3]);
                        *(u32x2*)(LA + off) = w1; *(u32x2*)(U + off) = w2;
                        asm volatile("" ::: "memory"); }
            }
        }
    }
};

template <bool ALIGN_EPI>
__device__ __forceinline__ void gemm_phase(LAS unsigned char* lds, const Gemm g, const StaticOrder& S, const Epi& E) {
    const int tid = threadIdx.x, wid = __builtin_amdgcn_readfirstlane(tid >> 6), lane = tid & 63, wr = wid >> 2, wc = wid & 3, fr = lane & 15, fq = lane >> 4;
    const int K = g.K, nt = K / BK;
    unsigned voffA[2], voffB[2];
#pragma unroll
    for (int i = 0; i < 2; ++i) { int R, C; stage_rc(tid * 16 + i * 8192, R, C); const int Rb = (R & ~31) + perm32(R & 31);
        voffA[i] = (unsigned)(R * g.lda + C) * 2u; voffB[i] = (unsigned)(Rb * g.ldb + C) * 2u; }
    constexpr unsigned kstep = BK * 2;
    const unsigned hstepA = (unsigned)(HALF * g.lda * 2), hstepB = (unsigned)(HALF * g.ldb * 2);
    const unsigned tstepA = 2 * hstepA, tstepB = 2 * hstepB;
    const unsigned ldsw = (unsigned)wid * 1024u;
    const int aoff = lds_byte(wr * 64 + fr, fq * 8), boff = lds_byte(wc * 32 + fr, fq * 8);
#define PG8_SA(b, h) (((b) * 2 + (h)) * HTB)
#define PG8_SB(b, h) ((4 + (b) * 2 + (h)) * HTB)
#define PG8_STAGE(bufoff, gbase, soff, voff) do { _Pragma("unroll") for (int _i = 0; _i < 2; ++_i) \
        __builtin_amdgcn_global_load_lds((const unsigned*)((gbase) + (size_t)(unsigned)((soff) + (voff)[_i])), (LAS unsigned*)(lds + (bufoff) + ldsw + _i * 8192), 16, 0, 0); } while (0)
#define PG8_LDA(dst, b, h) do { _Pragma("unroll") for (int m = 0; m < 4; ++m) _Pragma("unroll") for (int k = 0; k < 2; ++k) dst[m][k] = *(const LAS bf16x8*)(lds + PG8_SA(b, h) + aoff + m * 2048 + k * 1024); } while (0)
#define PG8_LDB(dst, b, h) do { _Pragma("unroll") for (int n = 0; n < 2; ++n) _Pragma("unroll") for (int k = 0; k < 2; ++k) dst[n][k] = *(const LAS bf16x8*)(lds + PG8_SB(b, h) + boff + n * 2048 + k * 1024); } while (0)
#define PG8_MMA(ai, bj, At, Bt) do { __builtin_amdgcn_s_setprio(1); _Pragma("unroll") for (int m = 0; m < 4; ++m) _Pragma("unroll") for (int n = 0; n < 2; ++n) _Pragma("unroll") for (int k = 0; k < 2; ++k) \
        acc[ai][bj][m][n] = __builtin_amdgcn_mfma_f32_16x16x32_bf16(Bt[n][k], At[m][k], acc[ai][bj][m][n], 0, 0, 0); __builtin_amdgcn_s_setprio(0); } while (0)
#define PG8_WAIT_V(n) asm volatile("s_waitcnt vmcnt(" #n ")" ::: "memory")
#define PG8_WAIT_L(n) asm volatile("s_waitcnt lgkmcnt(" #n ")" ::: "memory")
#define PG8_BAR __builtin_amdgcn_s_barrier()
#define PG8_SCHED __builtin_amdgcn_sched_barrier(0)
#define PG8_UA(u) ((unsigned)(u).pm * tstepA + (unsigned)(((u).pn >> g.apn_shift) * g.apn_elems) * 2u)
#define PG8_UB(u) ((unsigned)(u).pn * tstepB)
    const char* const Ab = (const char*)g.A; const char* const Bb = (const char*)g.Bt;
    Unit cur, nxt; int ui = 0;
    if (!S.next(0, cur)) return;
    f32x4 acc[2][2][4][2];
#pragma unroll
    for (int a = 0; a < 2; ++a)
#pragma unroll
        for (int b = 0; b < 2; ++b)
#pragma unroll
            for (int m = 0; m < 4; ++m)
#pragma unroll
                for (int n = 0; n < 2; ++n) acc[a][b][m][n] = (f32x4){0.f, 0.f, 0.f, 0.f};
    bf16x8 At[4][2], B0[2][2], B1[2][2];
    unsigned cA = PG8_UA(cur), cB = PG8_UB(cur);
    PG8_STAGE(PG8_SB(0, 0), Bb, cB, voffB); PG8_STAGE(PG8_SB(0, 1), Bb, cB + hstepB, voffB); PG8_STAGE(PG8_SA(0, 0), Ab, cA, voffA); PG8_STAGE(PG8_SA(0, 1), Ab, cA + hstepA, voffA);
    if (wr == 1) PG8_BAR;
    PG8_WAIT_V(2); PG8_BAR;
    PG8_STAGE(PG8_SB(1, 0), Bb, cB + kstep, voffB); PG8_STAGE(PG8_SA(1, 0), Ab, cA + kstep, voffA); PG8_STAGE(PG8_SB(1, 1), Bb, cB + hstepB + kstep, voffB);
    PG8_WAIT_V(6); PG8_BAR;
    for (;;) {
        const bool has_next = S.next(ui + 1, nxt);
        const unsigned nA = has_next ? PG8_UA(nxt) : cA; const unsigned nB = has_next ? PG8_UB(nxt) : cB;
#pragma nounroll
        for (int t = 0; t < nt; t += 2) {
            const bool last = (t == nt - 2);
            const unsigned a1 = cA + (unsigned)(t + 1) * kstep;
            const unsigned a2 = last ? nA : cA + (unsigned)(t + 2) * kstep; const unsigned b2 = last ? nB : cB + (unsigned)(t + 2) * kstep;
            const unsigned a3 = a2 + kstep; const unsigned b3 = b2 + kstep;
            PG8_LDB(B0, 0, 0); PG8_LDB(B1, 0, 1); PG8_SCHED; PG8_LDA(At, 0, 0); PG8_STAGE(PG8_SA(1, 1), Ab, a1 + hstepA, voffA);
            PG8_WAIT_V(8); PG8_WAIT_L(0); PG8_BAR; PG8_MMA(0, 0, At, B0); PG8_MMA(0, 1, At, B1); PG8_BAR; PG8_SCHED;
            PG8_LDA(At, 0, 1); PG8_STAGE(PG8_SB(0, 0), Bb, b2, voffB); PG8_STAGE(PG8_SB(0, 1), Bb, b2 + hstepB, voffB); PG8_STAGE(PG8_SA(0, 0), Ab, a2, voffA);
            PG8_WAIT_V(8); PG8_WAIT_L(0); PG8_BAR; PG8_MMA(1, 0, At, B0); PG8_MMA(1, 1, At, B1); PG8_BAR; PG8_SCHED;
            PG8_LDB(B0, 1, 0); PG8_LDB(B1, 1, 1); PG8_SCHED; PG8_LDA(At, 1, 0); PG8_STAGE(PG8_SA(0, 1), Ab, a2 + hstepA, voffA);
            PG8_WAIT_V(8); PG8_WAIT_L(0); PG8_BAR; PG8_MMA(0, 0, At, B0); PG8_MMA(0, 1, At, B1); PG8_BAR; PG8_SCHED;
            PG8_LDA(At, 1, 1); PG8_STAGE(PG8_SB(1, 0), Bb, b3, voffB); PG8_STAGE(PG8_SB(1, 1), Bb, b3 + hstepB, voffB); PG8_STAGE(PG8_SA(1, 0), Ab, a3, voffA);
            PG8_WAIT_V(8); PG8_WAIT_L(0); PG8_BAR; PG8_MMA(1, 0, At, B0); PG8_MMA(1, 1, At, B1); PG8_BAR; PG8_SCHED;
        }
        if constexpr (ALIGN_EPI) { if (wr == 0) PG8_BAR; }
        E(acc, cur, wr, wc, fr, fq);
        if (!has_next) break;
#pragma unroll
        for (int a = 0; a < 2; ++a)
#pragma unroll
            for (int b = 0; b < 2; ++b)
#pragma unroll
                for (int m = 0; m < 4; ++m)
#pragma unroll
                    for (int n = 0; n < 2; ++n) acc[a][b][m][n] = (f32x4){0.f, 0.f, 0.f, 0.f};
        cur = nxt; cA = nA; cB = nB; ++ui;
        if constexpr (ALIGN_EPI) { if (wr == 1) PG8_BAR; }
    }
    PG8_WAIT_V(0);
    if constexpr (!ALIGN_EPI) { if (wr == 0) PG8_BAR; }
    PG8_BAR;
#undef PG8_SA
#undef PG8_SB
#undef PG8_STAGE
#undef PG8_LDA
#undef PG8_LDB
#undef PG8_MMA
#undef PG8_WAIT_V
#undef PG8_WAIT_L
#undef PG8_BAR
#undef PG8_SCHED
#undef PG8_UA
#undef PG8_UB
}
}

namespace att {
typedef short v4i16_t __attribute__((ext_vector_type(4)));
constexpr int KPITCH = 144;
constexpr int KTILE = 64 * KPITCH;
constexpr int VTILE = 8192;
constexpr int OFF_K = 0, OFF_V = 2 * KTILE, OFF_BIAS = OFF_V + 2 * VTILE, OFF_FLAG = OFF_BIAS + 2064, LDS_BYTES = OFF_FLAG + 64;
constexpr float SB_CUT = -104.0f;
__device__ __forceinline__ int crow(int r, int hi) { return (r & 3) + 8 * (r >> 2) + 4 * hi; }
__device__ __forceinline__ v4i16_t vtr(LAS const unsigned char* p) { return __builtin_amdgcn_ds_read_tr16_b64_v4i16((LAS v4i16_t*)p); }

template <int MODE>
__device__ __forceinline__ void unit(const bf16_t* __restrict__ qkv, bf16_t* __restrict__ O, int b, int h, int qb, const float* __restrict__ relb, LAS unsigned char* lds) {
    const int tid = threadIdx.x, lane = tid & 63, l32 = lane & 31, hi = lane >> 5; const int w = __builtin_amdgcn_readfirstlane(tid >> 6);
    constexpr int QOFF = MODE == 0 ? 0 : 1536, KOFF = QOFF + 512, VOFF = QOFF + 1024, OOFF = MODE == 0 ? 0 : 512;
    const size_t rowbase = (size_t)b * SEQ;
    const int T0 = qb * 256 + w * 32;
    const int cw = 4 * qb + (w >> 1);
    bf16x8 qf[4];
    { const bf16_t* qp = qkv + (rowbase + T0 + l32) * QKVW + QOFF + h * 64 + hi * 8;
#pragma unroll
      for (int d0 = 0; d0 < 4; ++d0) qf[d0] = *(const bf16x8*)(qp + d0 * 16); }
    const int t_hi = 4 * qb + 3, t_lo = MODE == 0 ? (4 * qb - 8 > 0 ? 4 * qb - 8 : 0) : 0;
    const int n = t_hi - t_lo + 1;
    const bf16_t* Kg = qkv + rowbase * QKVW + KOFF + h * 64 + (size_t)(tid >> 3) * QKVW + (tid & 7) * 8;
    const bf16_t* Vg = qkv + rowbase * QKVW + VOFF + h * 64 + (size_t)(tid >> 3) * QKVW + (tid & 7) * 8;
    const int kst = (tid >> 3) * KPITCH + (tid & 7) * 16;
    const int vst = ((tid & 7) >> 2) * 4096 + (tid >> 3) * 64 + (tid & 3) * 16;
    LAS float* biasl = (LAS float*)(lds + OFF_BIAS);
    LAS int* flags = (LAS int*)(lds + OFF_FLAG);
    if (MODE == 0) { for (int i = tid; i < 513; i += 512) biasl[i] = relb[i] * LOG2E; }
#define TILE_OF(i) (MODE == 0 ? t_lo + (i) : t_hi - (i))
    u32x4 kreg, vreg;
    { const int t0 = TILE_OF(0); kreg = *(const u32x4*)(Kg + (size_t)t0 * 64 * QKVW); vreg = *(const u32x4*)(Vg + (size_t)t0 * 64 * QKVW); }
    *(LAS u32x4*)(lds + OFF_K + kst) = kreg; *(LAS u32x4*)(lds + OFF_V + vst) = vreg;
    __syncthreads();
    f32x16 o0 = {}, o1 = {};
    float mrun = -INFINITY, lsum = 0.f, carry = 0.f;
    bool alive = true;
    const int kfr = l32 * KPITCH + hi * 16;
    const int vfr = (4 * hi + ((lane & 15) >> 2)) * 64 + ((lane >> 4) & 1) * 32 + (lane & 3) * 8;
    const int tq = T0 + l32;
    for (int i = 0; i < n; ++i) {
        const int tile = TILE_OF(i); const int buf = i & 1;
        const bool more = (i + 1 < n);
        if (more) { const int t1 = TILE_OF(i + 1); kreg = *(const u32x4*)(Kg + (size_t)t1 * 64 * QKVW); vreg = *(const u32x4*)(Vg + (size_t)t1 * 64 * QKVW); }
        const bool act = MODE == 0 ? (tile >= cw - 8 && tile <= cw) : (tile <= cw && alive);
        if (act) {
            f32x16 p[2];
            LAS const unsigned char* kb_ = lds + OFF_K + buf * KTILE + kfr;
#pragma unroll
            for (int kb = 0; kb < 2; ++kb) { f32x16 a = {};
#pragma unroll
                for (int d0 = 0; d0 < 4; ++d0) { const bf16x8 kf = *(const LAS bf16x8*)(kb_ + kb * 32 * KPITCH + d0 * 32); a = __builtin_amdgcn_mfma_f32_32x32x16_bf16(kf, qf[d0], a, 0, 0, 0); }
                p[kb] = a; }
            const int tk0 = tile * 64 + 4 * hi;
            if (MODE == 0) {
                float rm = -INFINITY;
                const int rel0 = tq - tk0;
                const bool far = (T0 - tile * 64 - 63 >= 256);
                if (far) { const float bb = biasl[512];
#pragma unroll
                    for (int kb = 0; kb < 2; ++kb)
#pragma unroll
                        for (int r = 0; r < 16; ++r) { const float s = p[kb][r] * (0.125f * LOG2E) + bb; p[kb][r] = s; rm = fmaxf(rm, s); }
                } else {
#pragma unroll
                    for (int kb = 0; kb < 2; ++kb)
#pragma unroll
                        for (int r = 0; r < 16; ++r) { int rel = rel0 - 32 * kb - (r & 3) - 8 * (r >> 2); rel = rel > 256 ? 256 : rel;
                            const float s = p[kb][r] * (0.125f * LOG2E) + biasl[rel + 256]; p[kb][r] = s; rm = fmaxf(rm, s); }
                }
                rm = fmaxf(rm, __shfl_xor(rm, 32));
                const float mnew = fmaxf(mrun, rm); const float alpha = __builtin_amdgcn_exp2f(mrun - mnew); mrun = mnew;
                float ps = 0.f;
#pragma unroll
                for (int kb = 0; kb < 2; ++kb)
#pragma unroll
                    for (int r = 0; r < 16; ++r) { const float e = __builtin_amdgcn_exp2f(p[kb][r] - mnew); p[kb][r] = e; ps += e; }
                lsum = lsum * alpha + ps;
#pragma unroll
                for (int r = 0; r < 16; ++r) { o0[r] *= alpha; o1[r] *= alpha; }
            } else {
                const bool diag = (tile == cw);
                f32x16 l1v[2]; float G[8];
#pragma unroll
                for (int kb = 0; kb < 2; ++kb)
#pragma unroll
                    for (int g = 0; g < 4; ++g) { float gs = 0.f;
#pragma unroll
                        for (int e = 0; e < 4; ++e) { const int r = 4 * g + e; const float z = p[kb][r] * 0.125f;
                            const float sp = __builtin_amdgcn_logf(1.0f + __builtin_amdgcn_exp2f(-fabsf(z) * LOG2E)) * 0.6931471805599453f;
                            float lb = fminf(z, 0.f) - sp; float l1 = lb - z;
                            if (diag) { const int tk = tk0 + 32 * kb + 8 * g + e; if (tk >= tq) { l1 = 0.f; lb = -INFINITY; } }
                            p[kb][r] = lb; l1v[kb][r] = l1; gs += l1; }
                        G[4 * kb + g] = gs; }
                float Gp[8];
#pragma unroll
                for (int k = 0; k < 8; ++k) Gp[k] = __shfl_xor(G[k], 32);
                float R = 0.f; float suf[8];
#pragma unroll
                for (int k = 7; k >= 0; --k) { suf[k] = R + (hi == 0 ? Gp[k] : 0.f); R += G[k] + Gp[k]; }
#pragma unroll
                for (int kb = 0; kb < 2; ++kb)
#pragma unroll
                    for (int g = 0; g < 4; ++g) { float run = carry + suf[4 * kb + g];
#pragma unroll
                        for (int e = 3; e >= 0; --e) { const int r = 4 * g + e; const float wgt = __builtin_amdgcn_exp2f((p[kb][r] + run) * LOG2E); run += l1v[kb][r]; p[kb][r] = wgt; } }
                carry += R;
                alive = __builtin_amdgcn_ballot_w64(carry > SB_CUT) != 0ull;
            }
            bf16x8 pf[4];
#pragma unroll
            for (int ks = 0; ks < 4; ++ks) { const int kb = ks >> 1, r0 = 8 * (ks & 1);
                u32x4 t; t.x = cvtpk(p[kb][r0], p[kb][r0 + 1]); t.y = cvtpk(p[kb][r0 + 2], p[kb][r0 + 3]); t.z = cvtpk(p[kb][r0 + 4], p[kb][r0 + 5]); t.w = cvtpk(p[kb][r0 + 6], p[kb][r0 + 7]);
                pf[ks] = __builtin_bit_cast(bf16x8, t); }
            LAS const unsigned char* vb_ = lds + OFF_V + buf * VTILE + vfr;
#pragma unroll
            for (int ks = 0; ks < 4; ++ks) {
                { const v4i16_t lo = vtr(vb_ + ks * 1024), up = vtr(vb_ + ks * 1024 + 512);
                  const bf16x8 vf = {lo[0], lo[1], lo[2], lo[3], up[0], up[1], up[2], up[3]};
                  o0 = __builtin_amdgcn_mfma_f32_32x32x16_bf16(vf, pf[ks], o0, 0, 0, 0); }
                { const v4i16_t lo = vtr(vb_ + 4096 + ks * 1024), up = vtr(vb_ + 4096 + ks * 1024 + 512);
                  const bf16x8 vf = {lo[0], lo[1], lo[2], lo[3], up[0], up[1], up[2], up[3]};
                  o1 = __builtin_amdgcn_mfma_f32_32x32x16_bf16(vf, pf[ks], o1, 0, 0, 0); }
            }
        }
        if (more) { *(LAS u32x4*)(lds + OFF_K + (buf ^ 1) * KTILE + kst) = kreg; *(LAS u32x4*)(lds + OFF_V + (buf ^ 1) * VTILE + vst) = vreg; }
        if (MODE == 1) { if (lane == 0) flags[buf * 8 + w] = alive ? 1 : 0; }
        __syncthreads();
        if (MODE == 1) { int any = 0;
#pragma unroll
            for (int k = 0; k < 8; ++k) any |= flags[buf * 8 + k];
            if (!any) break; }
    }
    float inv = 1.0f;
    if (MODE == 0) { const float l = lsum + __shfl_xor(lsum, 32); inv = 1.0f / l; }
    bf16_t* op = O + (rowbase + T0 + l32) * DM + OOFF + h * 64 + 4 * hi;
#pragma unroll
    for (int g4 = 0; g4 < 4; ++g4) {
        u32x2 a, c; a.x = cvtpk(o0[4 * g4] * inv, o0[4 * g4 + 1] * inv); a.y = cvtpk(o0[4 * g4 + 2] * inv, o0[4 * g4 + 3] * inv);
        c.x = cvtpk(o1[4 * g4] * inv, o1[4 * g4 + 1] * inv); c.y = cvtpk(o1[4 * g4 + 2] * inv, o1[4 * g4 + 3] * inv);
        *(u32x2*)(op + 8 * g4) = a; *(u32x2*)(op + 32 + 8 * g4) = c; }
#undef TILE_OF
}
}

constexpr size_t MiB = 1u << 20;
constexpr size_t WS_NSP = 1 * MiB;
constexpr size_t WS_W_ATT_IN = 2 * MiB;
constexpr size_t WS_W_ATT_OUT = 14 * MiB;
constexpr size_t WS_W_RG_IN = 18 * MiB;
constexpr size_t WS_W_RG_OUT = 26 * MiB;
constexpr size_t WS_W_RG_GATES = 30 * MiB;
constexpr size_t WS_W_GU = 32 * MiB;
constexpr size_t WS_W_DOWN = 76 * MiB;
constexpr size_t WS_SUMP = 98 * MiB, WS_SUMH = 99 * MiB;
constexpr size_t WS_S0 = 100 * MiB, WS_S1 = 132 * MiB, WS_S2 = 164 * MiB, WS_S3 = 196 * MiB, WS_END = 228 * MiB;

struct Args {
    const float* x; const float* attn_w_in; const float* attn_rel_bias; const float* attn_w_out; const float* rg_w_in; const float* rg_conv_w; const float* rg_conv_b;
    const float* rg_w_a; const float* rg_b_a; const float* rg_w_i; const float* rg_b_i; const float* rg_lambda; const float* rg_w_out;
    const float* norm_mix_pre; const float* norm_mix_post; const float* norm_ffn_pre; const float* norm_ffn_post;
    const float* ffn_w_gate; const float* ffn_w_up; const float* ffn_w_down;
    float* out; unsigned char* ws;
};

#define XB_TMO      128
#define XB_XCNT(j)  (256  + 64 * (j))
#define XB_XSUB(j)  (1280 + 64 * (j))
#define XB_XGEN(j)  (2304 + 64 * (j))
#define XB_TOP      3328
#define XB_TOPGEN   3392
#define XCD_BAR_WORDS 3456
#define XB_SPIN_CAP (1u << 18)

__device__ __forceinline__ unsigned xb_ld(unsigned* p)              { return __hip_atomic_load(p, __ATOMIC_RELAXED, __HIP_MEMORY_SCOPE_AGENT); }
__device__ __forceinline__ unsigned xb_add(unsigned* p, unsigned v) { return __hip_atomic_fetch_add(p, v, __ATOMIC_RELAXED, __HIP_MEMORY_SCOPE_AGENT); }
__device__ __forceinline__ unsigned xb_xcc_id() { return (unsigned)__builtin_amdgcn_s_getreg((3 << 11) | 20) & 0xFu; }
#define XB_SPIN(cond, bar) do { unsigned _sp = 0; while (cond) { __builtin_amdgcn_s_sleep(1); \
    if ((++_sp & 255u) == 0u) { if (xb_ld(&(bar)[XB_TMO])) break; if (_sp > XB_SPIN_CAP) { atomicAdd(&(bar)[XB_TMO], 1u); break; } } } } while (0)

struct XcdBarrier {
    unsigned* bar; unsigned x;
    volatile LAS unsigned* st;
};

__device__ __forceinline__ XcdBarrier xcd_barrier_post(unsigned* bar, volatile LAS unsigned* st) {
    XcdBarrier b; b.bar = bar; b.x = xb_xcc_id(); b.st = st;
    if (threadIdx.x == 0) (void)xb_add(&bar[XB_XCNT(b.x)], 1u);
    return b;
}
__device__ __forceinline__ void xcd_barrier_complete(unsigned* bar, unsigned x, unsigned& nloc, unsigned& nx) {
    const unsigned G = gridDim.x * gridDim.y * gridDim.z;
    unsigned sum, cnt, mine, sp = 0u;
    for (;;) {
        sum = 0u; cnt = 0u; mine = 0u;
#pragma unroll
        for (unsigned j = 0; j < 16; ++j) { const unsigned c = xb_ld(&bar[XB_XCNT(j)]); sum += c; cnt += (c > 0u) ? 1u : 0u; mine = (j == x) ? c : mine; }
        if (sum == G) break;
        __builtin_amdgcn_s_sleep(1);
        if ((++sp & 255u) == 0u) { if (xb_ld(&bar[XB_TMO])) break; if (sp > XB_SPIN_CAP) { atomicAdd(&bar[XB_TMO], 1u); break; } }
    }
    nloc = mine > 0u ? mine : 1u; nx = cnt > 0u ? cnt : 1u;
}

__device__ __forceinline__ void xcd_barrier(const XcdBarrier& b) {
    asm volatile("s_waitcnt vmcnt(0)" ::: "memory");
    __syncthreads();
    if (threadIdx.x == 0) {
        unsigned* bar = b.bar;
        __builtin_amdgcn_s_waitcnt(0);
        unsigned nloc = b.st[0], nx = b.st[1];
        if (nloc == 0u) { xcd_barrier_complete(bar, b.x, nloc, nx); b.st[0] = nloc; b.st[1] = nx; }
        const unsigned old = xb_add(&bar[XB_XSUB(b.x)], 1u);
        const unsigned gen = old / nloc;
        if (old + 1u == (gen + 1u) * nloc) {
            __builtin_amdgcn_fence(__ATOMIC_RELEASE, "agent");
            asm volatile("s_waitcnt vmcnt(0)" ::: "memory");
            const unsigned og = xb_add(&bar[XB_TOP], 1u);
            const unsigned tg = og / nx;
            if (og + 1u == (tg + 1u) * nx) xb_add(&bar[XB_TOPGEN], 1u);
            else XB_SPIN(xb_ld(&bar[XB_TOPGEN]) == tg, bar);
            __builtin_amdgcn_fence(__ATOMIC_ACQUIRE, "agent");
            xb_add(&bar[XB_XGEN(b.x)], 1u);
            asm volatile("s_waitcnt vmcnt(0)" ::: "memory");
        } else {
            XB_SPIN(xb_ld(&bar[XB_XGEN(b.x)]) == gen, bar);
            __builtin_amdgcn_fence(__ATOMIC_ACQUIRE, "agent");
            asm volatile("s_waitcnt vmcnt(0)" ::: "memory");
        }
    }
    __syncthreads();
}


__device__ __forceinline__ unsigned long long karg_ld(int off) {
    auto kp = __builtin_amdgcn_kernarg_segment_ptr();
    unsigned long long r;
    asm volatile("s_load_dwordx2 %0, %1, %2\n\ts_waitcnt lgkmcnt(0)" : "=s"(r) : "s"(kp), "n"(off));
    return r;
}
#define KA(field) ((decltype(Args::field))karg_ld((int)__builtin_offsetof(Args, field)))
#define WSB(off) ((bf16_t*)(KA(ws) + (off)))
__device__ __forceinline__ float wave_sum(float v) {
#pragma unroll
    for (int o = 1; o < 64; o <<= 1) v += __shfl_xor(v, o);
    return v;
}
__device__ __forceinline__ void transpose_item(const float* __restrict__ W, int K, int N, bf16_t* __restrict__ WT, int base, bool inter, LAS float* scr, int item, int lane) {
    const int nblk = N / 32, kb = item / nblk, nb = item % nblk, k0 = 64 * kb, n0 = 32 * nb;
#pragma unroll 8
    for (int i = 0; i < 32; ++i) { const int kk = 2 * i + (lane >> 5); scr[kk * 33 + (lane & 31)] = W[(size_t)(k0 + kk) * N + n0 + (lane & 31)]; }
    asm volatile("s_waitcnt lgkmcnt(0)" ::: "memory");
    const int c = lane & 7;
    const int drow0 = base + (inter ? ((n0 >> 7) * 256 + (n0 & 127)) : n0);
#pragma unroll
    for (int j = 0; j < 4; ++j) { const int nn = (lane >> 3) + 8 * j; const LAS float* s = scr + (8 * c) * 33 + nn;
        u32x4 o; o.x = cvtpk(s[0 * 33], s[1 * 33]); o.y = cvtpk(s[2 * 33], s[3 * 33]); o.z = cvtpk(s[4 * 33], s[5 * 33]); o.w = cvtpk(s[6 * 33], s[7 * 33]);
        *(u32x4*)(WT + (size_t)(drow0 + nn) * K + k0 + 8 * c) = o; }
    asm volatile("s_waitcnt lgkmcnt(0)" ::: "memory");
}

constexpr int RP_ROWS = 4;
__device__ __forceinline__ void rowpass(const void* xin, bool xin_bf, const bf16_t* mrow, const float* __restrict__ gpost, void* xout, bool xout_bf,
                                        const float* __restrict__ gpre, bf16_t* hout, int gw, int NGW, int lane) {
    f32x4 gp[4], gq[4];
#pragma unroll
    for (int j = 0; j < 4; ++j) { gp[j] = mrow ? ((const f32x4*)gpost)[lane + 64 * j] : (f32x4){0.f, 0.f, 0.f, 0.f}; gq[j] = gpre ? ((const f32x4*)gpre)[lane + 64 * j] : (f32x4){0.f, 0.f, 0.f, 0.f}; }
    for (int row0 = gw; row0 < M; row0 += RP_ROWS * NGW) {
        f32x4 v[RP_ROWS][4], mv[RP_ROWS][4];
#pragma unroll
        for (int k = 0; k < RP_ROWS; ++k) { const size_t row = (size_t)row0 + (size_t)k * NGW;
            if (xin_bf) {
#pragma unroll
                for (int j = 0; j < 4; ++j) { const u32x2 t = ((const u32x2*)((const bf16_t*)xin + row * DM))[lane + 64 * j]; v[k][j] = (f32x4){bf_lo(t.x), bf_hi(t.x), bf_lo(t.y), bf_hi(t.y)}; }
            } else {
#pragma unroll
                for (int j = 0; j < 4; ++j) v[k][j] = ((const f32x4*)((const float*)xin + row * DM))[lane + 64 * j];
            }
            if (mrow) {
#pragma unroll
                for (int j = 0; j < 4; ++j) { const u32x2 t = ((const u32x2*)(mrow + row * DM))[lane + 64 * j]; mv[k][j] = (f32x4){bf_lo(t.x), bf_hi(t.x), bf_lo(t.y), bf_hi(t.y)}; }
            } }
#pragma unroll
        for (int k = 0; k < RP_ROWS; ++k) { const size_t row = (size_t)row0 + (size_t)k * NGW;
            if (mrow) { float s = 0.f;
#pragma unroll
                for (int j = 0; j < 4; ++j) s += (mv[k][j].x * mv[k][j].x + mv[k][j].y * mv[k][j].y) + (mv[k][j].z * mv[k][j].z + mv[k][j].w * mv[k][j].w);
                const float sc = 1.0f / sqrtf(wave_sum(s) * (1.0f / DM) + RMS_EPS);
#pragma unroll
                for (int j = 0; j < 4; ++j) v[k][j] = v[k][j] + mv[k][j] * sc * gp[j];
            }
            if (xout) {
                if (xout_bf) {
#pragma unroll
                    for (int j = 0; j < 4; ++j) { u32x2 t; t.x = cvtpk(v[k][j].x, v[k][j].y); t.y = cvtpk(v[k][j].z, v[k][j].w); ((u32x2*)((bf16_t*)xout + row * DM))[lane + 64 * j] = t;
                        v[k][j] = (f32x4){bf_lo(t.x), bf_hi(t.x), bf_lo(t.y), bf_hi(t.y)}; }
                } else {
#pragma unroll
                    for (int j = 0; j < 4; ++j) ((f32x4*)((float*)xout + row * DM))[lane + 64 * j] = v[k][j];
                }
            }
            if (gpre) {
                float s2 = 0.f;
#pragma unroll
                for (int j = 0; j < 4; ++j) s2 += (v[k][j].x * v[k][j].x + v[k][j].y * v[k][j].y) + (v[k][j].z * v[k][j].z + v[k][j].w * v[k][j].w);
                const float r = 1.0f / sqrtf(wave_sum(s2) * (1.0f / DM) + RMS_EPS);
#pragma unroll
                for (int j = 0; j < 4; ++j) { const f32x4 hv = v[k][j] * r * gq[j]; u32x2 t; t.x = cvtpk(hv.x, hv.y); t.y = cvtpk(hv.z, hv.w); ((u32x2*)(hout + row * DM))[lane + 64 * j] = t; }
            }
        }
    }
}

__device__ __forceinline__ void conv_phase(const bf16_t* __restrict__ xr, bf16_t* __restrict__ xc, const float* __restrict__ cw, const float* __restrict__ cbp, int gt, int nthr) {
    for (int it = gt; it < 1024 * 128; it += nthr) {
        const int cgp = it & 127, run = it >> 7, c0 = cgp * 8, r0 = run * 16;
        float cwt[4][8], cb[8];
#pragma unroll
        for (int t = 0; t < 4; ++t)
#pragma unroll
            for (int e = 0; e < 8; ++e) cwt[t][e] = cw[(size_t)t * DM + c0 + e];
#pragma unroll
        for (int e = 0; e < 8; ++e) cb[e] = cbp[c0 + e];
        float hst[3][8];
        const bool first = (r0 % SEQ) == 0;
#pragma unroll
        for (int t = 0; t < 3; ++t) { u32x4 q = {0u, 0u, 0u, 0u}; if (!first) q = *(const u32x4*)(xr + (size_t)(r0 - 3 + t) * DM + c0);
            hst[t][0] = bf_lo(q.x); hst[t][1] = bf_hi(q.x); hst[t][2] = bf_lo(q.y); hst[t][3] = bf_hi(q.y); hst[t][4] = bf_lo(q.z); hst[t][5] = bf_hi(q.z); hst[t][6] = bf_lo(q.w); hst[t][7] = bf_hi(q.w); }
#pragma unroll 4
        for (int r = 0; r < 16; ++r) {
            const u32x4 q = *(const u32x4*)(xr + (size_t)(r0 + r) * DM + c0);
            float cur[8] = {bf_lo(q.x), bf_hi(q.x), bf_lo(q.y), bf_hi(q.y), bf_lo(q.z), bf_hi(q.z), bf_lo(q.w), bf_hi(q.w)};
            float ov[8];
#pragma unroll
            for (int e = 0; e < 8; ++e) { ov[e] = cb[e] + cwt[0][e] * hst[0][e] + cwt[1][e] * hst[1][e] + cwt[2][e] * hst[2][e] + cwt[3][e] * cur[e];
                hst[0][e] = hst[1][e]; hst[1][e] = hst[2][e]; hst[2][e] = cur[e]; }
            u32x4 o; o.x = cvtpk(ov[0], ov[1]); o.y = cvtpk(ov[2], ov[3]); o.z = cvtpk(ov[4], ov[5]); o.w = cvtpk(ov[6], ov[7]);
            *(u32x4*)(xc + (size_t)(r0 + r) * DM + c0) = o;
        }
    }
}
__device__ __forceinline__ void scan1_phase(const bf16_t* __restrict__ LA, const bf16_t* __restrict__ U, float* __restrict__ sumP, float* __restrict__ sumH, int gt, int nthr) {
    for (int it = gt; it < 256 * 512; it += nthr) {
        const int cp = it & 511, ch = it >> 9; const size_t base = (size_t)ch * 64 * DM + cp * 2;
        float P0 = 1.f, P1 = 1.f, H0 = 0.f, H1 = 0.f;
#pragma unroll 8
        for (int r = 0; r < 64; ++r) { const unsigned la = *(const unsigned*)(LA + base + (size_t)r * DM), uu = *(const unsigned*)(U + base + (size_t)r * DM);
            const float a0 = fast_exp(bf_lo(la)), a1 = fast_exp(bf_hi(la));
            P0 *= a0; P1 *= a1; H0 = a0 * H0 + bf_lo(uu); H1 = a1 * H1 + bf_hi(uu); }
        *(f32x2*)(sumP + (size_t)ch * DM + cp * 2) = (f32x2){P0, P1}; *(f32x2*)(sumH + (size_t)ch * DM + cp * 2) = (f32x2){H0, H1};
    }
}
__device__ __forceinline__ void scan2_phase(const bf16_t* __restrict__ LA, const bf16_t* __restrict__ U, bf16_t* GT, const float* __restrict__ sumP, const float* __restrict__ sumH, int gt, int nthr) {
    for (int it = gt; it < 256 * 512; it += nthr) {
        const int cp = it & 511, ch = it >> 9, c = ch & 127, ch0 = ch - c; const size_t base = (size_t)ch * 64 * DM + cp * 2;
        float H0 = 0.f, H1 = 0.f;
#pragma unroll 8
        for (int k = 0; k < c; ++k) { const f32x2 p = *(const f32x2*)(sumP + (size_t)(ch0 + k) * DM + cp * 2), hh = *(const f32x2*)(sumH + (size_t)(ch0 + k) * DM + cp * 2);
            H0 = p.x * H0 + hh.x; H1 = p.y * H1 + hh.y; }
#pragma unroll 8
        for (int r = 0; r < 64; ++r) { const unsigned la = *(const unsigned*)(LA + base + (size_t)r * DM), uu = *(const unsigned*)(U + base + (size_t)r * DM), gg = *(const unsigned*)(GT + base + (size_t)r * DM);
            const float a0 = fast_exp(bf_lo(la)), a1 = fast_exp(bf_hi(la));
            H0 = a0 * H0 + bf_lo(uu); H1 = a1 * H1 + bf_hi(uu);
            *(unsigned*)(GT + base + (size_t)r * DM) = cvtpk(H0 * bf_lo(gg), H1 * bf_hi(gg)); }
    }
}

#ifndef PROBE
#define PROBE 0
#endif
constexpr int NTHREADS = 512, NWAVES = 8;
constexpr int LDS_BYTES = 147456;

__global__ void __launch_bounds__(NTHREADS, 2) mega_fwd(Args a) {
    extern __shared__ __attribute__((aligned(16))) unsigned char lds_raw[];
    LAS unsigned char* lds = (LAS unsigned char*)lds_raw;
    cg::grid_group grid = cg::this_grid();
    const int tid = threadIdx.x, lane = tid & 63; const int wave = __builtin_amdgcn_readfirstlane(tid >> 6);
    const int G = gridDim.x, bx = blockIdx.x;
    const int vcu = (G % 8 == 0) ? (bx % 8) * (G / 8) + bx / 8 : bx;
    const int gw = vcu * NWAVES + wave, NGW = G * NWAVES;
    volatile LAS unsigned* bst = (volatile LAS unsigned*)(lds + 131072 + 64);
    if (tid < 2) bst[tid] = 0u;
    __syncthreads();
    const XcdBarrier xbar = xcd_barrier_post((unsigned*)KA(ws), bst);
#define S0 WSB(WS_S0)
#define S1 WSB(WS_S1)
#define S2 WSB(WS_S2)
#define S3 WSB(WS_S3)
#define WSP KA(ws)

    {
        LAS float* scr = (LAS float*)(lds + wave * 16384);
        unsigned char* const wsl = WSP;
        int off = 0;
        for (int rep = 0; rep < ((PROBE & 4) ? 2 : 1); ++rep)
        for (int job = 0; job < 36; ++job) {
            const float* W; int K, N, base = 0; bool inter = false; bf16_t* WT;
            if (job < 2) { W = KA(attn_w_in) + (size_t)job * DM * QKVW; K = DM; N = QKVW; WT = (bf16_t*)(wsl + WS_W_ATT_IN) + (size_t)job * QKVW * DM; }
            else if (job < 4) { const int j = job - 2; W = KA(attn_w_out) + (size_t)j * DM * DM; K = DM; N = DM; WT = (bf16_t*)(wsl + WS_W_ATT_OUT) + (size_t)j * DM * DM; }
            else if (job < 6) { const int j = job - 4; W = KA(rg_w_in) + (size_t)j * DM * 2048; K = DM; N = 2048; WT = (bf16_t*)(wsl + WS_W_RG_IN) + (size_t)j * 2048 * DM; }
            else if (job < 8) { const int j = job - 6; W = KA(rg_w_out) + (size_t)j * DM * DM; K = DM; N = DM; WT = (bf16_t*)(wsl + WS_W_RG_OUT) + (size_t)j * DM * DM; }
            else if (job < 24) { const int idx = job - 8, j = idx >> 3, which = (idx >> 2) & 1, blk = idx & 3;
                W = (which ? KA(rg_w_i) : KA(rg_w_a)) + (size_t)(j * 4 + blk) * 65536; K = 256; N = 256; WT = (bf16_t*)(wsl + WS_W_RG_GATES) + (size_t)j * 2048 * 256; base = blk * 512 + which * 128; inter = true; }
            else if (job < 28) { const int l = job - 24; W = KA(ffn_w_gate) + (size_t)l * DM * DFF; K = DM; N = DFF; WT = (bf16_t*)(wsl + WS_W_GU) + (size_t)l * 2 * DFF * DM; base = 0; inter = true; }
            else if (job < 32) { const int l = job - 28; W = KA(ffn_w_up) + (size_t)l * DM * DFF; K = DM; N = DFF; WT = (bf16_t*)(wsl + WS_W_GU) + (size_t)l * 2 * DFF * DM; base = 128; inter = true; }
            else { const int l = job - 32; W = KA(ffn_w_down) + (size_t)l * DFF * DM; K = DFF; N = DM; WT = (bf16_t*)(wsl + WS_W_DOWN) + (size_t)l * DM * DFF; }
            const int nitems = (K / 64) * (N / 32);
            int first = gw - off; first %= NGW; if (first < 0) first += NGW;
            for (int it = first; it < nitems; it += NGW) transpose_item(W, K, N, WT, base, inter, scr, it, lane);
            off = (off + nitems) % NGW;
        }
    }
    { float* cst = (float*)(WSP + WS_NSP); const int gt = vcu * NTHREADS + tid; if (gt < 2 * DM) { const int jj = gt >> 10, c = gt & 1023;
        cst[jj * 3072 + c] = KA(rg_b_a)[gt]; cst[jj * 3072 + 1024 + c] = KA(rg_b_i)[gt]; cst[jj * 3072 + 2048 + c] = -8.0f * log1pf(expf(-KA(rg_lambda)[gt])); } }
    rowpass(KA(x), false, nullptr, nullptr, nullptr, false, KA(norm_mix_pre), S0, gw, NGW, lane);
    grid.sync();

    for (int step = 0; step <= DEPTH * 10; ++step) {
        const int layer = step / 10, sub = step - layer * 10, j = layer >> 1; const bool is_attn = (layer & 1) == 0, fin = (step == DEPTH * 10);
        if (!fin && is_attn && (sub == 3 || sub == 4 || sub == 5)) continue;
        if (step == 0) continue;
        if (fin || sub == 0 || sub == 7) {
            const void* xin; bool xin_bf = true; const bf16_t* mrow; const float* gpost; void* xout; bool xout_bf = true; const float* gpre; bf16_t* hout = S0;
            bf16_t* const XL = (bf16_t*)(WSP + WS_W_GU);
            if (fin) { xin = XL; mrow = S0; gpost = KA(norm_ffn_post) + (size_t)(DEPTH - 1) * DM; xout = KA(out); xout_bf = false; gpre = nullptr; hout = nullptr; }
            else if (sub == 0) { xin = KA(out); mrow = S0; gpost = KA(norm_ffn_post) + (size_t)(layer - 1) * DM; xout = KA(out); gpre = KA(norm_mix_pre) + (size_t)layer * DM; }
            else { if (layer == 0) { xin = KA(x); xin_bf = false; } else xin = KA(out);
                   mrow = is_attn ? S1 : S2; gpost = KA(norm_mix_post) + (size_t)layer * DM; xout = (layer == DEPTH - 1) ? (void*)XL : (void*)KA(out); gpre = KA(norm_ffn_pre) + (size_t)layer * DM; }
            rowpass(xin, xin_bf, mrow, gpost, xout, xout_bf, gpre, hout, gw, NGW, lane);
        } else if (sub == 1 || sub == 3 || sub == 6 || sub == 8 || sub == 9) {
            unsigned oA, oB, oP0, oP1 = 0; int N, K = DM, lda = DM, ldb = DM, ash = 0, ael = 0, mode = pg8::EPI_STORE, ldc = DM;
            if (sub == 1) { oA = WS_S0; if (is_attn) { oB = WS_W_ATT_IN + j * (QKVW * DM * 2); N = QKVW; oP0 = WS_S1; ldc = QKVW; }
                            else { oB = WS_W_RG_IN + j * (2048 * DM * 2); N = 2048; mode = pg8::EPI_RECIN; oP0 = WS_S1; oP1 = WS_S2; } }
            else if (sub == 3) { oA = WS_S3; oB = WS_W_RG_GATES + j * (2048 * 256 * 2); N = 2048; K = 256; ldb = 256; ash = 1; ael = 256; mode = pg8::EPI_GATES; oP0 = 0; oP1 = WS_NSP + j * (3072 * 4); }
            else if (sub == 6) { N = DM; if (is_attn) { oA = WS_S0; oB = WS_W_ATT_OUT + j * (DM * DM * 2); oP0 = WS_S1; } else { oA = WS_S1; oB = WS_W_RG_OUT + j * (DM * DM * 2); oP0 = WS_S2; } }
            else if (sub == 8) { oA = WS_S0; oB = WS_W_GU + layer * (2 * DFF * DM * 2); N = 2 * DFF; mode = pg8::EPI_SWIGLU; oP0 = WS_S1; ldc = DFF; }
            else { oA = WS_S1; oB = WS_W_DOWN + layer * (DM * DFF * 2); N = DM; K = DFF; lda = DFF; ldb = DFF; oP0 = WS_S0; }
            unsigned char* const wsl = WSP;
            pg8::Gemm g{(const bf16_t*)(wsl + oA), (const bf16_t*)(wsl + oB), K, lda, ldb, ash, ael}; pg8::StaticOrder S; S.init(M, N, G, bx);
            pg8::Epi E{mode, wsl + oP0, wsl + oP1, ldc};
            for (int rep = 0; rep < ((PROBE & 1) ? 2 : 1); ++rep) pg8::gemm_phase<true>(lds, g, S, E);
        } else if (sub == 2) {
            if (is_attn) {
                for (int rep = 0; rep < ((PROBE & 2) ? 2 : 1); ++rep)
                for (int uu = vcu; uu < 1024; uu += G) {
                    const int uidx = uu & 511;
                    const int qb = uidx & 31, hh = (uidx >> 5) & 7, bb = uidx >> 8;
                    if (uu < 512) att::unit<0>(S1, S0, bb, hh, qb, KA(attn_rel_bias) + (size_t)(j * 8 + hh) * 513, lds);
                    else att::unit<1>(S1, S0, bb, hh, qb, nullptr, lds);
                }
            } else for (int rep = 0; rep < ((PROBE & 16) ? 2 : 1); ++rep) conv_phase(S2, S3, KA(rg_conv_w) + (size_t)j * 4 * DM, KA(rg_conv_b) + (size_t)j * DM, vcu * NTHREADS + tid, G * NTHREADS);
        } else if (sub == 4) for (int rep = 0; rep < ((PROBE & 16) ? 2 : 1); ++rep) scan1_phase(S2, S0, (float*)(WSP + WS_SUMP), (float*)(WSP + WS_SUMH), vcu * NTHREADS + tid, G * NTHREADS);
        else scan2_phase(S2, S0, S1, (const float*)(WSP + WS_SUMP), (const float*)(WSP + WS_SUMH), vcu * NTHREADS + tid, G * NTHREADS);
        if (!fin) { xcd_barrier(xbar); if (PROBE & 8) xcd_barrier(xbar); }
    }
}

#undef WSP
#undef S0
#undef S1
#undef S2
#undef S3
extern "C" void kernel_launch(void* const* d_in, const int* in_sizes, int n_in, void* d_out, int out_size, void* d_ws, size_t ws_size, hipStream_t stream) {
    static int grid = 0;
    if (grid == 0) {
        if (n_in != 20 || in_sizes[0] != M * DM || out_size != M * DM || ws_size < WS_END) { fprintf(stderr, "kernel_launch: unexpected shapes (n_in %d, in0 %d, out %d, ws %zu); nothing launched\n", n_in, n_in > 0 ? in_sizes[0] : -1, out_size, ws_size); grid = -1; return; }
        int dev = 0, cus = 0, per_cu = 0;
        if (hipGetDevice(&dev) != hipSuccess || hipDeviceGetAttribute(&cus, hipDeviceAttributeMultiprocessorCount, dev) != hipSuccess) { grid = -1; return; }
        if (hipFuncSetAttribute((const void*)mega_fwd, hipFuncAttributeMaxDynamicSharedMemorySize, LDS_BYTES) != hipSuccess) { fprintf(stderr, "kernel_launch: hipFuncSetAttribute failed\n"); grid = -1; return; }
        if (hipOccupancyMaxActiveBlocksPerMultiprocessor(&per_cu, (const void*)mega_fwd, NTHREADS, LDS_BYTES) != hipSuccess || per_cu < 1) { fprintf(stderr, "kernel_launch: occupancy query says %d\n", per_cu); per_cu = 1; }
        (void)hipGetLastError();
        grid = cus * 1;
    }
    if (grid < 0) return;
    if (hipMemsetAsync(d_ws, 0, 16384, stream) != hipSuccess) { fprintf(stderr, "kernel_launch: memset of the barrier words failed\n"); return; }
    Args a{};
    a.x = (const float*)d_in[0]; a.attn_w_in = (const float*)d_in[1]; a.attn_rel_bias = (const float*)d_in[2]; a.attn_w_out = (const float*)d_in[3];
    a.rg_w_in = (const float*)d_in[4]; a.rg_conv_w = (const float*)d_in[5]; a.rg_conv_b = (const float*)d_in[6]; a.rg_w_a = (const float*)d_in[7]; a.rg_b_a = (const float*)d_in[8];
    a.rg_w_i = (const float*)d_in[9]; a.rg_b_i = (const float*)d_in[10]; a.rg_lambda = (const float*)d_in[11]; a.rg_w_out = (const float*)d_in[12];
    a.norm_mix_pre = (const float*)d_in[13]; a.norm_mix_post = (const float*)d_in[14]; a.norm_ffn_pre = (const float*)d_in[15]; a.norm_ffn_post = (const float*)d_in[16];
    a.ffn_w_gate = (const float*)d_in[17]; a.ffn_w_up = (const float*)d_in[18]; a.ffn_w_down = (const float*)d_in[19];
    a.out = (float*)d_out; a.ws = (unsigned char*)d_ws;
    void* args[] = {&a};
    hipError_t e = hipLaunchCooperativeKernel((const void*)mega_fwd, dim3(grid), dim3(NTHREADS), args, LDS_BYTES, stream);
    if (e != hipSuccess) fprintf(stderr, "kernel_launch: cooperative launch failed: %s (grid %d)\n", hipGetErrorString(e), grid);
}
```
